# Optimizing an MI355X kernel written in HIP

```python
import math
import jax, jax.numpy as jnp
from jax import lax
import numpy as np

D_MODEL = 1024
BATCH = 16
SEQ = 256
DEPTH = 2
DEC_BATCH = 8
DEC_SEQ = 2048
PAST_LEN = 512

GRID_W = 64
RW_HEADS = 4
RW_N = 64
RW_W = RW_HEADS * RW_N
RW_LORA_W = 64
RW_LORA_A = 64
RW_LORA_G = 128
RW_DIR = RW_LORA_W + RW_LORA_A + RW_LORA_G
RW_IN = 3 * RW_W + 2 * RW_DIR
RW_GN_EPS = 64e-5
GLA_HEADS = 4
GLA_DK = 32
GLA_DV = 64
GLA_QK = GLA_HEADS * GLA_DK
GLA_W = GLA_HEADS * GLA_DV
GLA_LORA = 16
GLA_DIR = GLA_LORA + GLA_W
GLA_IN = 2 * GLA_QK + GLA_W + 2 * GLA_DIR
GLA_TAU = 16.0
GLA_CHUNK = 64
DIFF_HEADS = 4
DIFF_D = 64
DIFF_W = DIFF_HEADS * 2 * DIFF_D
DIFF_IN = 3 * DIFF_W
Q_BLOCK = 128
ROPE_BASE = 10000.0
MIX_W = RW_W + GLA_W + DIFF_W
IN_W = RW_IN + GLA_IN + DIFF_IN
D_FF = 2816
N_MOD = 9
LN_EPS = 1e-5
NORM_EPS = 1e-6
ALPHA = (2 * DEPTH) ** 0.25
BETA = (8 * DEPTH) ** -0.25
F32 = jnp.float32

kernel_name = 'hybrid_rwkv7_gla_diffattn_dit_step'


def layer_norm(x, g, b):
    xf = x.astype(F32)
    mu = jnp.mean(xf, -1, keepdims=True)
    var = jnp.mean(jnp.square(xf - mu), -1, keepdims=True)
    return ((xf - mu) * lax.rsqrt(var + LN_EPS) * g + b).astype(x.dtype)


def head_layer_norm(y, eps):
    mu = jnp.mean(y, -1, keepdims=True)
    var = jnp.mean(jnp.square(y - mu), -1, keepdims=True)
    return (y - mu) * lax.rsqrt(var + eps)


def head_rms_norm(y, eps):
    yf = y.astype(F32)
    return yf * lax.rsqrt(jnp.mean(jnp.square(yf), -1, keepdims=True) + eps)


def swiglu(h, wg, wu, wd):
    return (jax.nn.silu(h @ wg) * (h @ wu)) @ wd


def centred_shift(p, mu):
    prev = jnp.pad(p[:, :-1], ((0, 0), (1, 0), (0, 0)))
    nxt = jnp.pad(p[:, 1:], ((0, 0), (0, 1), (0, 0)))
    return p + mu[0] * (prev - p) + mu[1] * (nxt - p)


def axial_rope(x):
    t = x.shape[1]
    rows = t // GRID_W
    row_pos = jnp.repeat(jnp.arange(rows, dtype=F32), GRID_W)
    col_pos = jnp.tile(jnp.arange(GRID_W, dtype=F32), rows)
    half = x.shape[-1] // 2
    nf = half // 2
    inv = ROPE_BASE ** (-jnp.arange(nf, dtype=F32) / nf)
    xf = x.astype(F32)

    def rot(part, pos):
        ang = pos[:, None] * inv
        cos = jnp.cos(ang)[None, :, None, None, :]
        sin = jnp.sin(ang)[None, :, None, None, :]
        x1, x2 = part[..., :nf], part[..., nf:]
        return jnp.concatenate([x1 * cos - x2 * sin, x1 * sin + x2 * cos], -1)

    out = jnp.concatenate([rot(xf[..., :half], row_pos), rot(xf[..., half:], col_pos)], -1)
    return out.astype(x.dtype)


def rwkv7_scan(r, w, k, v, kk, a, s0):
    def step(s, inp):
        r_t, w_t, k_t, v_t, kk_t, a_t = inp
        sa = jnp.einsum('bhvk,bhk->bhv', s, kk_t)
        s = (s * w_t[:, :, None, :] - sa[..., None] * (kk_t * a_t)[:, :, None, :]
             + v_t[..., None] * k_t[:, :, None, :])
        y = jnp.einsum('bhvk,bhk->bhv', s, r_t)
        return s, y

    xs = tuple(jnp.moveaxis(t, 1, 0) for t in (r, w, k, v, kk, a))
    s_fin, ys = lax.scan(step, s0, xs)
    return jnp.moveaxis(ys, 0, 1), s_fin


def gla_chunked(q, k, v, log_a, s0):
    bsz, t, h, _ = q.shape
    n = t // GLA_CHUNK

    def to_chunks(x):
        return jnp.transpose(x.reshape(bsz, n, GLA_CHUNK, h, x.shape[-1]), (1, 0, 3, 2, 4))

    mask = jnp.tril(jnp.ones((GLA_CHUNK, GLA_CHUNK), bool))[None, None, :, :, None]

    def step(s, inp):
        qc, kc, vc, lc = inp
        b = jnp.cumsum(lc, axis=2)
        b_last = b[:, :, -1:, :]
        o_inter = jnp.einsum('bhtd,bhde->bhte', qc * jnp.exp(b), s)
        diff = b[:, :, :, None, :] - b[:, :, None, :, :]
        dec = jnp.where(mask, jnp.exp(jnp.minimum(diff, 0.0)), 0.0)
        attn = jnp.einsum('bhtd,bhsd,bhtsd->bhts', qc, kc, dec)
        o = o_inter + jnp.einsum('bhts,bhse->bhte', attn, vc)
        s = (jnp.exp(b_last[:, :, 0, :])[..., None] * s
             + jnp.einsum('bhsd,bhse->bhde', kc * jnp.exp(b_last - b), vc))
        return s, o

    s_fin, o = lax.scan(step, s0, tuple(to_chunks(x) for x in (q, k, v, log_a)))
    o = jnp.transpose(o, (1, 0, 3, 2, 4)).reshape(bsz, t, h, v.shape[-1])
    return o, s_fin


def diff_attention(q, k, v, lam):
    bsz, tq, h, _, d = q.shape
    nb = tq // Q_BLOCK
    qb = jnp.moveaxis(q.reshape(bsz, nb, Q_BLOCK, h, 2, d), 1, 0)

    def one_block(qblk):
        s = jnp.einsum('bqhcd,bkhcd->bhcqk', qblk, k).astype(F32)
        p = jax.nn.softmax(s, axis=-1)
        att = p[:, :, 0] - lam * p[:, :, 1]
        return jnp.einsum('bhqk,bkhe->bqhe', att.astype(v.dtype), v)

    o = lax.map(one_block, qb)
    return jnp.moveaxis(o, 0, 1).reshape(bsz, tq, h, 2 * d)


def rwkv7_branch(p, s0, lp):
    p = centred_shift(p.astype(F32), lp['rw_mu'])
    bsz, t, _ = p.shape
    r, k, v, dir_f, dir_b = jnp.split(p, [RW_W, 2 * RW_W, 3 * RW_W, 3 * RW_W + RW_DIR], -1)

    def heads(x):
        return x.reshape(bsz, t, RW_HEADS, RW_N)

    kk = heads(k * lp['rw_k_k'])
    kk = kk / jnp.maximum(jnp.sqrt(jnp.sum(jnp.square(kk), -1, keepdims=True)), 1e-12)
    rh, vh = heads(r), heads(v)
    out = jnp.zeros((bsz, t, RW_W), F32)
    states = []
    for d, pd in enumerate((dir_f, dir_b)):
        wd, ad, gd = jnp.split(pd, [RW_LORA_W, RW_LORA_W + RW_LORA_A], -1)
        w_raw = lp['rw_w0'][d] + jnp.tanh(wd) @ lp['rw_w_up'][d]
        decay = jnp.exp(-jnp.exp(-jax.nn.softplus(-w_raw) - 0.5))
        a = jax.nn.sigmoid(lp['rw_a0'][d] + ad @ lp['rw_a_up'][d])
        g = jax.nn.sigmoid(gd) @ lp['rw_g_up'][d]
        kd = heads(k * (1.0 + (a - 1.0) * lp['rw_k_a']))
        seq = (rh, heads(decay), kd, vh, kk, heads(a))
        if d == 1:
            seq = tuple(jnp.flip(x, 1) for x in seq)
        y, s_fin = rwkv7_scan(*seq, s0[:, d].astype(F32))
        if d == 1:
            y = jnp.flip(y, 1)
        y = head_layer_norm(y, RW_GN_EPS).reshape(bsz, t, RW_W) * lp['rw_gn_g'][d] + lp['rw_gn_b'][d]
        bonus = (jnp.sum(rh * kd * lp['rw_r_k'][d], -1, keepdims=True) * vh).reshape(bsz, t, RW_W)
        out = out + (y + bonus) * g
        states.append(s_fin)
    return out, jnp.stack(states, 1)


def gla_branch(p, s0, lp):
    p = p.astype(F32)
    bsz, t, _ = p.shape
    q, k, v, dir_f, dir_b = jnp.split(
        p, [GLA_QK, 2 * GLA_QK, 2 * GLA_QK + GLA_W, 2 * GLA_QK + GLA_W + GLA_DIR], -1)
    q = q.reshape(bsz, t, GLA_HEADS, GLA_DK) * GLA_DK ** -0.5
    k = k.reshape(bsz, t, GLA_HEADS, GLA_DK)
    v = v.reshape(bsz, t, GLA_HEADS, GLA_DV)
    out = jnp.zeros((bsz, t, GLA_W), F32)
    states = []
    for d, pd in enumerate((dir_f, dir_b)):
        ad, gd = jnp.split(pd, [GLA_LORA], -1)
        log_a = jax.nn.log_sigmoid(ad @ lp['gla_a_up'][d] + lp['gla_a_b'][d]) / GLA_TAU
        seq = (q, k, v, log_a.reshape(bsz, t, GLA_HEADS, GLA_DK))
        if d == 1:
            seq = tuple(jnp.flip(x, 1) for x in seq)
        o, s_fin = gla_chunked(*seq, s0[:, d].astype(F32))
        if d == 1:
            o = jnp.flip(o, 1)
        o = head_rms_norm(o, NORM_EPS) * lp['gla_gn_g']
        out = out + o.reshape(bsz, t, GLA_W) * jax.nn.silu(gd)
        states.append(s_fin)
    return out, jnp.stack(states, 1)


def diff_branch(p, ctx_kv, lp, lam_init):
    bsz, t, _ = p.shape
    q, k, v = jnp.split(p, 3, -1)
    q = q.reshape(bsz, t, DIFF_HEADS, 2, DIFF_D)
    k = k.reshape(bsz, t, DIFF_HEADS, 2, DIFF_D)
    v = v.reshape(bsz, t, DIFF_HEADS, 2 * DIFF_D)
    lam_p = lp['diff_lam'].astype(F32)
    lam = jnp.exp(jnp.sum(lam_p[0] * lam_p[1])) - jnp.exp(jnp.sum(lam_p[2] * lam_p[3])) + lam_init
    if ctx_kv is None:
        keys, vals = k, v
        new_k, new_v = k.reshape(bsz, t, DIFF_HEADS, 2 * DIFF_D), v
    else:
        k_ctx, v_ctx = ctx_kv
        q = axial_rope(q)
        keys = jnp.concatenate(
            [axial_rope(k), k_ctx.reshape(bsz, -1, DIFF_HEADS, 2, DIFF_D).astype(k.dtype)], 1)
        vals = jnp.concatenate([v, v_ctx.astype(v.dtype)], 1)
        new_k, new_v = None, None
    o = diff_attention(q * DIFF_D ** -0.5, keys, vals, lam)
    o = head_rms_norm(o, NORM_EPS) * lp['diff_gn_g'] * (1.0 - lam_init)
    return o.reshape(bsz, t, DIFF_W), new_k, new_v


def token_mixer(h, lp, lam_init, cache):
    bsz = h.shape[0]
    p = h @ lp['w_in']
    p_rw, p_gla, p_diff = jnp.split(p, [RW_IN, RW_IN + GLA_IN], -1)
    if cache is None:
        s_rw0 = jnp.zeros((bsz, 2, RW_HEADS, RW_N, RW_N), F32)
        s_gla0 = jnp.zeros((bsz, 2, GLA_HEADS, GLA_DK, GLA_DV), F32)
        ctx_kv = None
    else:
        s_rw0, s_gla0, k_ctx, v_ctx = cache
        ctx_kv = (k_ctx, v_ctx)
    o_rw, s_rw = rwkv7_branch(p_rw, s_rw0, lp)
    o_gla, s_gla = gla_branch(p_gla, s_gla0, lp)
    o_diff, new_k, new_v = diff_branch(p_diff, ctx_kv, lp, lam_init)
    mixed = jnp.concatenate([o_rw, o_gla, o_diff.astype(F32)], -1).astype(h.dtype)
    out = mixed @ lp['w_out']
    if cache is None:
        return out, (s_rw.astype(h.dtype), s_gla.astype(h.dtype), new_k, new_v)
    return out, None


def trunk_layer(x, cond, lp, lam_init, cache):
    sh1, sc1, g1, sh2, sc2, g2, sh3, sc3, g3 = jnp.split(cond.astype(x.dtype), N_MOD, -1)
    h = x * (1.0 + sc1) + sh1
    f = swiglu(h, lp['ffn_w_gate'][0], lp['ffn_w_up'][0], lp['ffn_w_down'][0])
    x = layer_norm(ALPHA * x + 0.5 * g1 * f, lp['ln_g'][0], lp['ln_b'][0])
    h = x * (1.0 + sc2) + sh2
    m, new_cache = token_mixer(h, lp, lam_init, cache)
    x = layer_norm(ALPHA * x + g2 * m, lp['ln_g'][1], lp['ln_b'][1])
    h = x * (1.0 + sc3) + sh3
    f = swiglu(h, lp['ffn_w_gate'][1], lp['ffn_w_up'][1], lp['ffn_w_down'][1])
    x = layer_norm(ALPHA * x + 0.5 * g3 * f, lp['ln_g'][2], lp['ln_b'][2])
    return x, new_cache


def setup_inputs(seed: int = 0) -> dict:
    key = jax.random.key(seed)
    ks = iter(jax.random.split(key, 40))

    def nrm(shape, scale):
        return scale * jax.random.normal(next(ks), shape, F32)

    def unif(shape, lo, hi):
        return jax.random.uniform(next(ks), shape, F32, lo, hi)

    L = DEPTH
    return {
        'x_prompt': nrm((BATCH, SEQ, D_MODEL), 1.0),
        'x_sample': nrm((DEC_BATCH, DEC_SEQ, D_MODEL), 1.0),
        'state_rwkv': nrm((DEC_BATCH, L, 2, RW_HEADS, RW_N, RW_N), 1.0),
        'state_gla': nrm((DEC_BATCH, L, 2, GLA_HEADS, GLA_DK, GLA_DV), 1.0),
        'cache_diff_k': nrm((DEC_BATCH, L, PAST_LEN, DIFF_HEADS, 2 * DIFF_D), 1.0),
        'cache_diff_v': nrm((DEC_BATCH, L, PAST_LEN, DIFF_HEADS, 2 * DIFF_D), 1.0),
        'c': nrm((DEC_BATCH, D_MODEL), 1.0),
        'c_ctx': nrm((D_MODEL,), 1.0),
        'w_ada': nrm((L, D_MODEL, N_MOD * D_MODEL), 0.5 * D_MODEL ** -0.5),
        'b_ada': nrm((L, N_MOD * D_MODEL), 0.01),
        'ln_g': 1.0 + nrm((L, 3, D_MODEL), 0.02),
        'ln_b': nrm((L, 3, D_MODEL), 0.02),
        'ffn_w_gate': nrm((L, 2, D_MODEL, D_FF), D_MODEL ** -0.5),
        'ffn_w_up': nrm((L, 2, D_MODEL, D_FF), D_MODEL ** -0.5),
        'ffn_w_down': nrm((L, 2, D_FF, D_MODEL), BETA * D_FF ** -0.5),
        'w_in': nrm((L, D_MODEL, IN_W), D_MODEL ** -0.5),
        'w_out': nrm((L, MIX_W, D_MODEL), BETA * MIX_W ** -0.5),
        'rw_mu': unif((L, 2, RW_IN), 0.0, 0.5),
        'rw_k_k': 0.85 + nrm((L, RW_W), 0.1),
        'rw_k_a': 1.0 + nrm((L, RW_W), 0.1),
        'rw_w0': unif((L, 2, RW_W), -6.0, -1.0),
        'rw_w_up': nrm((L, 2, RW_LORA_W, RW_W), 0.5 * RW_LORA_W ** -0.5),
        'rw_a0': nrm((L, 2, RW_W), 0.1),
        'rw_a_up': nrm((L, 2, RW_LORA_A, RW_W), 0.5 * RW_LORA_A ** -0.5),
        'rw_g_up': nrm((L, 2, RW_LORA_G, RW_W), RW_LORA_G ** -0.5),
        'rw_r_k': nrm((L, 2, RW_HEADS, RW_N), 0.1),
        'rw_gn_g': 1.0 + nrm((L, 2, RW_W), 0.02),
        'rw_gn_b': nrm((L, 2, RW_W), 0.02),
        'gla_a_up': nrm((L, 2, GLA_LORA, GLA_QK), GLA_LORA ** -0.5),
        'gla_a_b': 2.0 + nrm((L, 2, GLA_QK), 0.5),
        'gla_gn_g': 1.0 + nrm((L, GLA_DV), 0.02),
        'diff_lam': nrm((L, 4, DIFF_D), 0.1),
        'diff_gn_g': 1.0 + nrm((L, 2 * DIFF_D), 0.02),
    }


def reference(x_prompt, x_sample, state_rwkv, state_gla, cache_diff_k, cache_diff_v, c, c_ctx,
              w_ada, b_ada, ln_g, ln_b, ffn_w_gate, ffn_w_up, ffn_w_down, w_in, w_out,
              rw_mu, rw_k_k, rw_k_a, rw_w0, rw_w_up, rw_a0, rw_a_up, rw_g_up, rw_r_k,
              rw_gn_g, rw_gn_b, gla_a_up, gla_a_b, gla_gn_g, diff_lam, diff_gn_g):
    y_p = x_prompt
    y_s = x_sample
    new_rw, new_gla, new_k, new_v = [], [], [], []
    for l in range(DEPTH):
        lp = {
            'w_in': w_in[l], 'w_out': w_out[l], 'ln_g': ln_g[l], 'ln_b': ln_b[l],
            'ffn_w_gate': ffn_w_gate[l], 'ffn_w_up': ffn_w_up[l], 'ffn_w_down': ffn_w_down[l],
            'rw_mu': rw_mu[l], 'rw_k_k': rw_k_k[l], 'rw_k_a': rw_k_a[l], 'rw_w0': rw_w0[l],
            'rw_w_up': rw_w_up[l], 'rw_a0': rw_a0[l], 'rw_a_up': rw_a_up[l], 'rw_g_up': rw_g_up[l],
            'rw_r_k': rw_r_k[l], 'rw_gn_g': rw_gn_g[l], 'rw_gn_b': rw_gn_b[l],
            'gla_a_up': gla_a_up[l], 'gla_a_b': gla_a_b[l], 'gla_gn_g': gla_gn_g[l],
            'diff_lam': diff_lam[l], 'diff_gn_g': diff_gn_g[l],
        }
        lam_init = 0.8 - 0.6 * math.exp(-0.3 * l)
        cond_ctx = (jax.nn.silu(c_ctx)[None, :] @ w_ada[l] + b_ada[l])[:, None, :]
        y_p, (s_rw, s_gla, k_c, v_c) = trunk_layer(y_p, cond_ctx, lp, lam_init, None)
        new_rw.append(s_rw)
        new_gla.append(s_gla)
        new_k.append(k_c)
        new_v.append(v_c)
        cond_lat = (jax.nn.silu(c) @ w_ada[l] + b_ada[l])[:, None, :]
        cache_l = (state_rwkv[:, l], state_gla[:, l], cache_diff_k[:, l], cache_diff_v[:, l])
        y_s, _ = trunk_layer(y_s, cond_lat, lp, lam_init, cache_l)
    return (y_p, y_s, jnp.stack(new_rw, 1), jnp.stack(new_gla, 1), jnp.stack(new_k, 1), jnp.stack(new_v, 1))
```

```cpp
#include <hip/hip_runtime.h>
#include <hip/hip_cooperative_groups.h>
#include <cstdio>
namespace cg = cooperative_groups;
namespace pg8 {
#define PG8_LAS __attribute__((address_space(3)))
typedef unsigned short bf16_t;
typedef short bf16x8 __attribute__((ext_vector_type(8)));
typedef float f32x4 __attribute__((ext_vector_type(4)));
typedef unsigned u32x4 __attribute__((ext_vector_type(4)));
constexpr int BM = 256, BK = 64, HALF = 128, HTB = HALF * BK * 2  , STAGE_BYTES = 8 * HTB, NXCD = 8, WGM = 8;

__host__ __device__ __forceinline__ int lds_byte(int r, int c) { const int st = (r >> 4) * 2 + (c >> 5), rr = r & 15, cc = c & 31, ob = rr * 64 + cc * 2; return st * 1024 + (ob ^ (((ob >> 9) & 1) << 5)); }
__host__ __device__ __forceinline__ void stage_rc(int b, int& R, int& C) { const int st = b / 1024, sb = b % 1024, swz = sb ^ (((sb >> 9) & 1) << 5); R = (st >> 1) * 16 + swz / 64; C = (st & 1) * 32 + (swz % 64) / 2; }
__host__ __device__ __forceinline__ int perm32(int rho) { const int n = rho >> 4, i = rho & 15; return 8 * (i >> 2) + 4 * n + (i & 3); }

struct Unit { int pm, pn; };
struct Gemm { const bf16_t* A; const bf16_t* Bt; int M, N, K; };

struct StaticOrder {
    int nM, nN, nwg, G, c;
    __host__ __device__ void init(int M, int N, int G_, int c_) { nM = M / BM; nN = N / BM; nwg = nM * nN; G = G_; c = c_; }
    __host__ __device__ bool next(int i, Unit& u) const {
        const long L = (long)i * G + c; if (L >= nwg) return false;
        int wgid = (int)L; { const int q = nwg / NXCD, r = nwg % NXCD, xcd = wgid % NXCD, off = wgid / NXCD; wgid = (xcd < r ? xcd * (q + 1) : r * (q + 1) + (xcd - r) * q) + off; }
        const int nig = WGM * nN, gid = wgid / nig, fm = gid * WGM, gsz = (nM - fm) < WGM ? (nM - fm) : WGM;
        u.pm = fm + ((wgid % nig) % gsz); u.pn = (wgid % nig) / gsz; return true;
    }
    __device__ __forceinline__ void a_ready(const Unit&) const {}
    __device__ __forceinline__ void done(const Unit&) const {}
};
__device__ __forceinline__ unsigned cvt_pk_bf16(float lo, float hi) { unsigned r; asm volatile("v_cvt_pk_bf16_f32 %0, %1, %2" : "=v"(r) : "v"(lo), "v"(hi)); return r; }
typedef float f32x2 __attribute__((ext_vector_type(2)));
template <class Epi, class Sched, bool STAMP = false>
__device__ __forceinline__ void gemm_phase(PG8_LAS unsigned char* lds, const Gemm g, const Sched& S, const Epi& E, unsigned long long* stamps) {
    int tid_ = threadIdx.x; asm volatile("" : "+v"(tid_));
    const int tid = tid_, wid = __builtin_amdgcn_readfirstlane(tid >> 6), lane = tid & 63, wr = wid >> 2, wc = wid & 3, fr = lane & 15, fq = lane >> 4;
    const int K = g.K, nt = K / BK;
    int ts_lo = 0, ts_hi = 0, nts = 0; const unsigned long long rt_entry = STAMP ? (unsigned long long)wall_clock64() : 0ull;
#define PG8_STAMP() do { if (STAMP && wid == 0 && nts < 64) { const unsigned long long _c = (unsigned long long)clock64(); \
        ts_lo = (lane == nts) ? (int)(unsigned)_c : ts_lo; ts_hi = (lane == nts) ? (int)(unsigned)(_c >> 32) : ts_hi; ++nts; } } while (0)
    PG8_STAMP();
    unsigned voffA[2], voffB[2];
#pragma unroll
    for (int i = 0; i < 2; ++i) { int R, C; stage_rc(tid * 16 + i * 8192, R, C); const int Rb = Epi::PERM ? ((R & ~31) + perm32(R & 31)) : R;
        voffA[i] = (unsigned)(R * K + C) * 2u; voffB[i] = (unsigned)(Rb * K + C) * 2u; }
    const size_t kstep = (size_t)(BK * 2);
    const size_t hstep = (size_t)HALF * K * 2;
    const size_t tstep = 2 * hstep;
    const unsigned ldsw = (unsigned)wid * 1024u;
    const int aoff = lds_byte(wr * 64 + fr, fq * 8), boff = lds_byte(wc * 32 + fr, fq * 8);
#define PG8_SA(b, h) (((b) * 2 + (h)) * HTB)
#define PG8_SB(b, h) ((4 + (b) * 2 + (h)) * HTB)
#define PG8_STAGE(bufoff, gbase, voff) do { _Pragma("unroll") for (int _i = 0; _i < 2; ++_i) \
        __builtin_amdgcn_global_load_lds((const unsigned*)((const char*)(gbase) + (voff)[_i]), (PG8_LAS unsigned*)(lds + (bufoff) + ldsw + _i * 8192), 16, 0, 0); } while (0)
#define PG8_LDA(dst, b, h) do { _Pragma("unroll") for (int m = 0; m < 4; ++m) _Pragma("unroll") for (int k = 0; k < 2; ++k) dst[m][k] = *(const PG8_LAS bf16x8*)(lds + PG8_SA(b, h) + aoff + m * 2048 + k * 1024); } while (0)
#define PG8_LDB(dst, b, h) do { _Pragma("unroll") for (int n = 0; n < 2; ++n) _Pragma("unroll") for (int k = 0; k < 2; ++k) dst[n][k] = *(const PG8_LAS bf16x8*)(lds + PG8_SB(b, h) + boff + n * 2048 + k * 1024); } while (0)
#define PG8_MMA(ai, bj, At, Bt) do { __builtin_amdgcn_s_setprio(1); _Pragma("unroll") for (int m = 0; m < 4; ++m) _Pragma("unroll") for (int n = 0; n < 2; ++n) _Pragma("unroll") for (int k = 0; k < 2; ++k) \
        acc[ai][bj][m][n] = __builtin_amdgcn_mfma_f32_16x16x32_bf16(Bt[n][k], At[m][k], acc[ai][bj][m][n], 0, 0, 0); __builtin_amdgcn_s_setprio(0); } while (0)
#define PG8_WAIT_V(n) asm volatile("s_waitcnt vmcnt(" #n ")" ::: "memory")
#define PG8_WAIT_L(n) asm volatile("s_waitcnt lgkmcnt(" #n ")" ::: "memory")
#define PG8_BAR __builtin_amdgcn_s_barrier()
#define PG8_SCHED __builtin_amdgcn_sched_barrier(0)
    Unit cur, nxt; int ui = 0;
    if (!S.next(0, cur)) return;
    f32x4 acc[2][2][4][2];
#pragma unroll
    for (int a = 0; a < 2; ++a)
#pragma unroll
        for (int b = 0; b < 2; ++b)
#pragma unroll
            for (int m = 0; m < 4; ++m)
#pragma unroll
                for (int n = 0; n < 2; ++n) acc[a][b][m][n] = (f32x4){0.f, 0.f, 0.f, 0.f};
    bf16x8 At[4][2], B0[2][2], B1[2][2];
    const char* cA = (const char*)g.A + (size_t)cur.pm * tstep; const char* cB = (const char*)g.Bt + (size_t)cur.pn * tstep;
    S.a_ready(cur);
    PG8_STAGE(PG8_SB(0, 0), cB, voffB); PG8_STAGE(PG8_SA(0, 0), cA, voffA); PG8_STAGE(PG8_SB(0, 1), cB + hstep, voffB); PG8_STAGE(PG8_SA(0, 1), cA + hstep, voffA);
    if (wr == 1) PG8_BAR;
    PG8_WAIT_V(4); PG8_BAR;
    PG8_STAGE(PG8_SB(1, 0), cB + kstep, voffB); PG8_STAGE(PG8_SA(1, 0), cA + kstep, voffA); PG8_STAGE(PG8_SB(1, 1), cB + hstep + kstep, voffB);
    PG8_WAIT_V(6); PG8_BAR;
    PG8_STAMP();
    for (;;) {
        const bool has_next = S.next(ui + 1, nxt);
        const char* nA = has_next ? (const char*)g.A + (size_t)nxt.pm * tstep : cA; const char* nB = has_next ? (const char*)g.Bt + (size_t)nxt.pn * tstep : cB;
        for (int t = 0; t < nt; t += 2) {
            const bool last = (t == nt - 2);
            const char* a1 = cA + (size_t)(t + 1) * kstep;
            const char* a2 = last ? nA : cA + (size_t)(t + 2) * kstep; const char* b2 = last ? nB : cB + (size_t)(t + 2) * kstep;
            const char* a3 = a2 + kstep; const char* b3 = b2 + kstep;
            if (last && has_next) S.a_ready(nxt);
            PG8_LDB(B0, 0, 0); PG8_SCHED; PG8_LDA(At, 0, 0); PG8_STAGE(PG8_SA(1, 1), a1 + hstep, voffA);
            PG8_WAIT_L(8); PG8_BAR; PG8_WAIT_L(0); PG8_MMA(0, 0, At, B0); PG8_BAR; PG8_SCHED;
            PG8_LDB(B1, 0, 1); PG8_STAGE(PG8_SB(0, 0), b2, voffB);
            PG8_BAR; PG8_WAIT_L(0); PG8_MMA(0, 1, At, B1); PG8_BAR;
            PG8_LDA(At, 0, 1); PG8_STAGE(PG8_SA(0, 0), a2, voffA);
            PG8_BAR; PG8_WAIT_L(0); PG8_MMA(1, 0, At, B0); PG8_BAR; PG8_SCHED;
            PG8_STAGE(PG8_SB(0, 1), b2 + hstep, voffB);
            PG8_WAIT_V(6); PG8_BAR; PG8_MMA(1, 1, At, B1); PG8_BAR;
            PG8_LDB(B0, 1, 0); PG8_SCHED; PG8_LDA(At, 1, 0); PG8_STAGE(PG8_SA(0, 1), a2 + hstep, voffA);
            PG8_WAIT_L(8); PG8_BAR; PG8_WAIT_L(0); PG8_MMA(0, 0, At, B0); PG8_BAR; PG8_SCHED;
            PG8_LDB(B1, 1, 1); PG8_STAGE(PG8_SB(1, 0), b3, voffB);
            PG8_BAR; PG8_WAIT_L(0); PG8_MMA(0, 1, At, B1); PG8_BAR;
            PG8_LDA(At, 1, 1); PG8_STAGE(PG8_SA(1, 0), a3, voffA);
            PG8_BAR; PG8_WAIT_L(0); PG8_MMA(1, 0, At, B0); PG8_BAR; PG8_SCHED;
            PG8_STAGE(PG8_SB(1, 1), b3 + hstep, voffB);
            PG8_WAIT_V(6); PG8_BAR; PG8_MMA(1, 1, At, B1); PG8_BAR;
        }
        PG8_STAMP();
        if constexpr (!Epi::AFTER_DRAIN) { E(acc, cur, wr, wc, fr, fq); S.done(cur); }
        PG8_STAMP();
        if (!has_next) break;
#pragma unroll
        for (int a = 0; a < 2; ++a)
#pragma unroll
            for (int b = 0; b < 2; ++b)
#pragma unroll
                for (int m = 0; m < 4; ++m)
#pragma unroll
                    for (int n = 0; n < 2; ++n) acc[a][b][m][n] = (f32x4){0.f, 0.f, 0.f, 0.f};
        cur = nxt; cA = nA; cB = nB; ++ui;
    }
    PG8_WAIT_V(0);
    if (wr == 0) PG8_BAR;
    PG8_BAR;
    if constexpr (Epi::AFTER_DRAIN) { E.fused(acc, cur, wr, wc, fr, fq, lds, wid, lane); S.done(cur); }
    PG8_STAMP();
    if (STAMP && wid == 0) { stamps[lane] = lane < nts ? (((unsigned long long)(unsigned)ts_hi << 32) | (unsigned)ts_lo) : 0ull;
        if (lane == 62) stamps[62] = rt_entry; if (lane == 63) stamps[63] = (unsigned long long)wall_clock64(); }
#undef PG8_STAMP
#undef PG8_SA
#undef PG8_SB
#undef PG8_STAGE
#undef PG8_LDA
#undef PG8_LDB
#undef PG8_MMA
#undef PG8_WAIT_V
#undef PG8_WAIT_L
#undef PG8_BAR
#undef PG8_SCHED
}
}
using namespace pg8;
#define LAS __attribute__((address_space(3)))
typedef unsigned u32x2 __attribute__((ext_vector_type(2)));

constexpr int MTOK = 20480, MCTX = 4096;
constexpr float ALPHA = 1.41421356237f;
struct Params { const float* in[33]; float* out; unsigned char* ws; };
typedef const __attribute__((address_space(3))) Params& PR;
enum { I_XP = 0, I_XS, I_SRW, I_SGLA, I_CK, I_CV, I_C, I_CCTX, I_WADA, I_BADA, I_LNG, I_LNB, I_WG, I_WU, I_WDN, I_WIN, I_WOUT,
       I_MU, I_KK, I_KA, I_W0, I_WUP, I_A0, I_AUP, I_GUP, I_RK, I_GNG, I_GNB, I_GAUP, I_GAB, I_GGN, I_LAM, I_DGN };
constexpr size_t O_Y = 0, O_NRW = 20971520, O_NGLA = 22020096, O_NK = 22544384, O_NV = 26738688;
constexpr size_t WS_CTL = 0;
constexpr size_t WS_COND = 4096;
constexpr size_t WS_WGU = WS_COND + 663552;
constexpr size_t WS_WD = WS_WGU + 2ull * 5632 * 1024 * 2;
constexpr size_t WS_WIN = WS_WD + 2ull * 1024 * 2816 * 2;
constexpr size_t WS_WOUT = WS_WIN + 4096ull * 1024 * 2;
constexpr size_t WS_H = WS_WOUT + 1024ull * 1536 * 2;
constexpr size_t WS_BIG = WS_H + 20480ull * 1536 * 2;
constexpr size_t WS_ACT = WS_BIG;
constexpr size_t WS_P = WS_BIG;
constexpr size_t WS_Q = WS_P + 20480ull * 2336 * 2;
constexpr size_t WS_K = WS_Q + 20480ull * 512 * 2;
constexpr size_t WS_VT = WS_K + 24576ull * 512 * 2;
constexpr size_t WS_EAG = WS_VT + 24576ull * 512 * 2;
constexpr size_t WS_GLA = WS_EAG + 2ull * 20480 * 768 * 2;
constexpr size_t WS_END = WS_GLA + 2ull * 20480 * 128 * 4;
constexpr size_t VT_LAT_OFF = 16ull * 512 * 256;

__device__ __forceinline__ int ltid() { int t = threadIdx.x; asm volatile("" : "+v"(t)); return t; }
__device__ __forceinline__ int lbid() { int t = blockIdx.x; asm volatile("" : "+s"(t)); return t; }
__device__ __forceinline__ int condrow(int m) { return m < MCTX ? 0 : 1 + ((m - MCTX) >> 11); }
__device__ __forceinline__ float wave_sum(float v) {
#pragma unroll
    for (int o = 32; o >= 1; o >>= 1) v += __shfl_xor(v, o);
    return v;
}
__device__ __forceinline__ float bf2f(bf16_t b) { return __uint_as_float(((unsigned)b) << 16); }
__device__ __forceinline__ bf16_t f2bf(float f) { return (bf16_t)(cvt_pk_bf16(f, 0.f) & 0xffffu); }

__device__ __forceinline__ float wsrc(PR P, int l, int type, int f, int r, int k) {
    if (type == 0) { const int g = r >> 5, i = r & 31; const float* src = (i < 16 ? P.in[I_WG] : P.in[I_WU]) + ((size_t)(l * 2 + f) * 1024 + k) * 2816; return src[16 * g + (i & 15)]; }
    if (type == 1) return P.in[I_WDN][((size_t)(l * 2 + f) * 2816 + k) * 1024 + r];
    if (type == 2) { int col; if (r < 512) col = 2336 + r; else if (r < 1024) col = 2848 + (r - 512); else if (r < 2304) col = r - 1024; else if (r < 3360) col = 1280 + (r - 2304); else if (r < 3584) return 0.f; else col = 3360 + (r - 3584);
        return P.in[I_WIN][((size_t)l * 1024 + k) * 3872 + col]; }
    const int kr = k < 512 ? (k & 255) : (k < 1024 ? 256 + ((k - 512) & 255) : k - 512);
    return P.in[I_WOUT][((size_t)l * 1024 + kr) * 1024 + r];
}
__device__ void convert_weights(PR P, int l, LAS float* tile) {
    const int tid = ltid();
    for (int u = lbid(); u < 5632; u += gridDim.x) {
        int type, f = 0, rt, kt, K; bf16_t* dst; int v = u;
        if (v < 2816) { type = 0; f = v / 1408; v %= 1408; rt = v / 16; kt = v % 16; K = 1024; dst = (bf16_t*)(P.ws + WS_WGU) + (size_t)f * 5632 * 1024; }
        else if ((v -= 2816) < 1408) { type = 1; f = v / 704; v %= 704; rt = v / 44; kt = v % 44; K = 2816; dst = (bf16_t*)(P.ws + WS_WD) + (size_t)f * 1024 * 2816; }
        else if ((v -= 1408) < 1024) { type = 2; rt = v / 16; kt = v % 16; K = 1024; dst = (bf16_t*)(P.ws + WS_WIN); }
        else { v -= 1024; type = 3; rt = v / 24; kt = v % 24; K = 1536; dst = (bf16_t*)(P.ws + WS_WOUT); }
        const int r0 = rt * 64, k0 = kt * 64;
        { const int rl = tid & 63, kb = tid >> 6;
#pragma unroll
          for (int j = 0; j < 8; ++j) { const int kk = kb + 8 * j; tile[rl * 65 + kk] = wsrc(P, l, type, f, r0 + rl, k0 + kk); } }
        __syncthreads();
        { const int rl = tid >> 3, ks = (tid & 7) * 8; const LAS float* t = tile + rl * 65 + ks;
          u32x4 w; w.x = cvt_pk_bf16(t[0], t[1]); w.y = cvt_pk_bf16(t[2], t[3]); w.z = cvt_pk_bf16(t[4], t[5]); w.w = cvt_pk_bf16(t[6], t[7]);
          *(u32x4*)(dst + (size_t)(r0 + rl) * K + k0 + ks) = w; }
        __syncthreads();
    }
}
__device__ void cond_phase(PR P, LAS float* lf) {
    const int tid = ltid(), lane = tid & 63, w = tid >> 6;
    LAS float* sc = lf; LAS float* red = lf + 9 * 1024;
    for (int i = tid; i < 9 * 1024; i += 512) { const int j = i >> 10, k = i & 1023; const float c = (j == 0) ? P.in[I_CCTX][k] : P.in[I_C][(j - 1) * 1024 + k]; sc[i] = c / (1.f + expf(-c)); }
    __syncthreads();
    for (int u = lbid(); u < 288; u += gridDim.x) {
        const int l = u / 144, n0 = (u % 144) * 64;
        const float* wa = P.in[I_WADA] + (size_t)l * 1024 * 9216 + n0 + lane;
        float acc[9];
#pragma unroll
        for (int j = 0; j < 9; ++j) acc[j] = 0.f;
#pragma unroll 2
        for (int k = w * 128; k < w * 128 + 128; k += 4) {
            const float w0 = wa[(size_t)k * 9216], w1 = wa[(size_t)(k + 1) * 9216], w2 = wa[(size_t)(k + 2) * 9216], w3 = wa[(size_t)(k + 3) * 9216];
#pragma unroll
            for (int j = 0; j < 9; ++j) { const f32x4 s = *(const LAS f32x4*)(sc + j * 1024 + k); acc[j] += s.x * w0 + s.y * w1 + s.z * w2 + s.w * w3; }
        }
#pragma unroll
        for (int j = 0; j < 9; ++j) red[(w * 9 + j) * 64 + lane] = acc[j];
        __syncthreads();
        for (int i = tid; i < 576; i += 512) { const int j = i >> 6, ln = i & 63; float s = 0.f;
#pragma unroll
            for (int ww = 0; ww < 8; ++ww) s += red[(ww * 9 + j) * 64 + ln];
            ((float*)(P.ws + WS_COND))[((size_t)l * 9 + j) * 9216 + n0 + ln] = s + P.in[I_BADA][l * 9216 + n0 + ln]; }
        __syncthreads();
    }
}
__device__ void mod_phase0(PR P) {
    bf16_t* H = (bf16_t*)(P.ws + WS_H); const float* cond = (const float*)(P.ws + WS_COND);
    const int c = ltid() * 2;
    for (int m = lbid(); m < MTOK; m += gridDim.x) {
        const float* x = (m < MCTX) ? P.in[I_XP] + (size_t)m * 1024 : P.in[I_XS] + (size_t)(m - MCTX) * 1024;
        const float* cr = cond + (size_t)condrow(m) * 9216;
        const float2 xv = *(const float2*)(x + c), sh = *(const float2*)(cr + c), sc = *(const float2*)(cr + 1024 + c);
        *(unsigned*)(H + (size_t)m * 1024 + c) = cvt_pk_bf16(xv.x * (1.f + sc.x) + sh.x, xv.y * (1.f + sc.y) + sh.y);
    }
}
__device__ void ln_phase(PR P, int l, int which, int nextmod, int lc) {
    float* X = P.out; bf16_t* H = (bf16_t*)(P.ws + WS_H);
    const float* g = P.in[I_LNG] + (l * 3 + which) * 1024; const float* b = P.in[I_LNB] + (l * 3 + which) * 1024;
    const float* cond = (const float*)(P.ws + WS_COND) + (size_t)lc * 9 * 9216;
    const int lane = ltid() & 63, w = ltid() >> 6;
    for (int m = lbid() * 8 + w; m < MTOK; m += gridDim.x * 8) {
        float* xr = X + (size_t)m * 1024 + lane * 4;
        f32x4 v[4]; float s = 0.f;
#pragma unroll
        for (int i = 0; i < 4; ++i) { v[i] = *(const f32x4*)(xr + i * 256); s += (v[i][0] + v[i][1]) + (v[i][2] + v[i][3]); }
        const float mu = wave_sum(s) * (1.f / 1024.f);
        float q = 0.f;
#pragma unroll
        for (int i = 0; i < 4; ++i) { const f32x4 d = v[i] - mu; q += (d[0] * d[0] + d[1] * d[1]) + (d[2] * d[2] + d[3] * d[3]); }
        const float rstd = 1.0f / sqrtf(wave_sum(q) * (1.f / 1024.f) + 1e-5f);
        const float* cr = cond + (size_t)condrow(m) * 9216 + nextmod * 1024 + lane * 4;
#pragma unroll
        for (int i = 0; i < 4; ++i) {
            const f32x4 gv = *(const f32x4*)(g + i * 256 + lane * 4), bv = *(const f32x4*)(b + i * 256 + lane * 4);
            const f32x4 y = (v[i] - mu) * rstd * gv + bv;
            *(f32x4*)(xr + i * 256) = y;
            if (nextmod >= 0) { const f32x4 sh = *(const f32x4*)(cr + i * 256), sc = *(const f32x4*)(cr + 1024 + i * 256); const f32x4 h = y * (1.f + sc) + sh;
                u32x2 wv; wv.x = cvt_pk_bf16(h[0], h[1]); wv.y = cvt_pk_bf16(h[2], h[3]); *(u32x2*)(H + (size_t)m * 1024 + i * 256 + lane * 4) = wv; }
        }
    }
}
struct EpiAct {
    static constexpr bool PERM = false, AFTER_DRAIN = false; bf16_t* O;
    __device__ __forceinline__ void operator()(const f32x4 (&acc)[2][2][4][2], const Unit& u, int wr, int wc, int fr, int fq) const {
        const int row0 = u.pm * 256 + wr * 64 + fr, ff0 = u.pn * 128 + wc * 16 + 4 * fq;
#pragma unroll
        for (int ai = 0; ai < 2; ++ai)
#pragma unroll
            for (int m = 0; m < 4; ++m) { bf16_t* rowp = O + (size_t)(row0 + ai * 128 + m * 16) * 2816 + ff0;
#pragma unroll
                for (int bj = 0; bj < 2; ++bj) { const f32x4 g = acc[ai][bj][m][0], up = acc[ai][bj][m][1]; float a[4];
#pragma unroll
                    for (int j = 0; j < 4; ++j) a[j] = g[j] / (1.f + __expf(-g[j])) * up[j];
                    u32x2 w; w.x = cvt_pk_bf16(a[0], a[1]); w.y = cvt_pk_bf16(a[2], a[3]); *(u32x2*)(rowp + bj * 64) = w; } }
    }
};
struct EpiRes {
    static constexpr bool PERM = false, AFTER_DRAIN = false; const float* xp; const float* xs; float* X; const float* cond; int gidx; float gs;
    __device__ __forceinline__ void operator()(const f32x4 (&acc)[2][2][4][2], const Unit& u, int wr, int wc, int fr, int fq) const {
        const int row0 = u.pm * 256 + wr * 64 + fr, col0 = u.pn * 256 + wc * 32 + 4 * fq;
#pragma unroll
        for (int ai = 0; ai < 2; ++ai)
#pragma unroll
            for (int m = 0; m < 4; ++m) { const int row = row0 + ai * 128 + m * 16;
                const float* xr = (row < MCTX ? xp + (size_t)row * 1024 : xs + (size_t)(row - MCTX) * 1024) + col0;
                const float* gr = cond + (size_t)condrow(row) * 9216 + gidx * 1024 + col0; float* o = X + (size_t)row * 1024 + col0;
#pragma unroll
                for (int bj = 0; bj < 2; ++bj)
#pragma unroll
                    for (int n = 0; n < 2; ++n) { const int off = bj * 128 + n * 16; const f32x4 xv = *(const f32x4*)(xr + off), gv = *(const f32x4*)(gr + off);
                        *(f32x4*)(o + off) = ALPHA * xv + gs * gv * acc[ai][bj][m][n]; } }
    }
};
struct EpiIn {
    static constexpr bool PERM = false, AFTER_DRAIN = false; bf16_t* Q; bf16_t* Kb; bf16_t* Pb; float* newk;
    __device__ __forceinline__ void operator()(const f32x4 (&acc)[2][2][4][2], const Unit& u, int wr, int wc, int fr, int fq) const {
        const int row0 = u.pm * 256 + wr * 64 + fr;
        if (u.pn >= 4) {
            const int colbase = (u.pn - 4) * 256 + wc * 32 + 4 * fq;
#pragma unroll
            for (int ai = 0; ai < 2; ++ai)
#pragma unroll
                for (int m = 0; m < 4; ++m) { bf16_t* rowp = Pb + (size_t)(row0 + ai * 128 + m * 16) * 2336;
#pragma unroll
                    for (int bj = 0; bj < 2; ++bj)
#pragma unroll
                        for (int n = 0; n < 2; ++n) { const int col = colbase + bj * 128 + n * 16; const f32x4 a = acc[ai][bj][m][n];
                            if (col < 2336) { u32x2 w; w.x = cvt_pk_bf16(a[0], a[1]); w.y = cvt_pk_bf16(a[2], a[3]); *(u32x2*)(rowp + col) = w; } } }
        } else {
            const bool isK = u.pn >= 2, lat = u.pm >= 16;
            const int chbase = (u.pn & 1) * 256 + wc * 32 + 4 * fq;
            float invf[4];
#pragma unroll
            for (int j = 0; j < 4; ++j) invf[j] = __builtin_amdgcn_exp2f(-(float)(4 * fq + j) * 0.83048202372f) * 0.15915494309f;
#pragma unroll
            for (int ai = 0; ai < 2; ++ai)
#pragma unroll
                for (int m = 0; m < 4; ++m) { const int row = row0 + ai * 128 + m * 16;
                    float cs[4], sn[4]; int t = 0, b = 0;
                    if (lat) { t = (row - MCTX) & 2047; b = (row - MCTX) >> 11; const float pos = (float)((wc & 1) ? (t & 63) : (t >> 6));
#pragma unroll
                        for (int j = 0; j < 4; ++j) { const float rev = pos * invf[j]; cs[j] = __builtin_amdgcn_cosf(rev); sn[j] = __builtin_amdgcn_sinf(rev); } }
                    else {
#pragma unroll
                        for (int j = 0; j < 4; ++j) { cs[j] = 1.f; sn[j] = 0.f; } }
#pragma unroll
                    for (int bj = 0; bj < 2; ++bj) { const f32x4 x1 = acc[ai][bj][m][0], x2 = acc[ai][bj][m][1]; float o1[4], o2[4];
#pragma unroll
                        for (int j = 0; j < 4; ++j) { o1[j] = x1[j] * cs[j] - x2[j] * sn[j]; o2[j] = x1[j] * sn[j] + x2[j] * cs[j]; }
                        const int ch = chbase + bj * 128;
                        if (!isK) { bf16_t* q = Q + (size_t)row * 512 + ch; u32x2 w;
                            w.x = cvt_pk_bf16(o1[0] * 0.125f, o1[1] * 0.125f); w.y = cvt_pk_bf16(o1[2] * 0.125f, o1[3] * 0.125f); *(u32x2*)q = w;
                            w.x = cvt_pk_bf16(o2[0] * 0.125f, o2[1] * 0.125f); w.y = cvt_pk_bf16(o2[2] * 0.125f, o2[3] * 0.125f); *(u32x2*)(q + 16) = w; }
                        else { const size_t krow = lat ? (size_t)(MCTX + b * 2560 + t) : (size_t)row; bf16_t* kp = Kb + krow * 512 + ch; u32x2 w;
                            w.x = cvt_pk_bf16(o1[0], o1[1]); w.y = cvt_pk_bf16(o1[2], o1[3]); *(u32x2*)kp = w;
                            w.x = cvt_pk_bf16(o2[0], o2[1]); w.y = cvt_pk_bf16(o2[2], o2[3]); *(u32x2*)(kp + 16) = w;
                            if (!lat) { float* nk = newk + ((size_t)(row >> 8) * 512 + (row & 255)) * 512 + ch; *(f32x4*)nk = x1; *(f32x4*)(nk + 16) = x2; } } } }
        }
    }
};
struct EpiVt {
    static constexpr bool PERM = false, AFTER_DRAIN = false; bf16_t* Vt; float* newv;
    __device__ __forceinline__ void operator()(const f32x4 (&acc)[2][2][4][2], const Unit& u, int wr, int wc, int fr, int fq) const {
        const int ch0 = u.pm * 256 + wr * 64 + fr, tok0 = u.pn * 256 + wc * 32 + 4 * fq;
#pragma unroll
        for (int ai = 0; ai < 2; ++ai)
#pragma unroll
            for (int m = 0; m < 4; ++m) { const int ch = ch0 + ai * 128 + m * 16;
#pragma unroll
                for (int bj = 0; bj < 2; ++bj)
#pragma unroll
                    for (int n = 0; n < 2; ++n) { const int tok = tok0 + bj * 128 + n * 16; const f32x4 a = acc[ai][bj][m][n]; size_t addr;
                        if (u.pn < 16) { const int b = u.pn, t = tok - 256 * b; addr = ((size_t)(b * 512 + ch)) * 256 + t; float* nv = newv + ((size_t)b * 512 + t) * 512 + ch;
                            nv[0] = a[0]; nv[512] = a[1]; nv[1024] = a[2]; nv[1536] = a[3]; }
                        else { const int tl = tok - MCTX, b = tl >> 11, t = tl & 2047; addr = VT_LAT_OFF + ((size_t)(b * 512 + ch)) * 2560 + t; }
                        u32x2 w; w.x = cvt_pk_bf16(a[0], a[1]); w.y = cvt_pk_bf16(a[2], a[3]); *(u32x2*)(Vt + addr) = w; } }
    }
};
__device__ void prep_phase(PR P, int l, LAS float* lin  ) {
    const int tid = ltid();
    const bf16_t* Pb = (const bf16_t*)(P.ws + WS_P);
    bf16_t* EAG = (bf16_t*)(P.ws + WS_EAG); float* GLA = (float*)(P.ws + WS_GLA);
    for (int u = lbid(); u < 1280 + 256; u += gridDim.x) {
        if (u < 1280) {
            const int m0 = u * 16; const bool lat = m0 >= MCTX; const int T = lat ? 2048 : 256; const int t0 = lat ? ((m0 - MCTX) & 2047) : (m0 & 255);
            {
                const int d = tid >> 8, cc = tid & 255, col = 768 + tid;
                const float mu0 = P.in[I_MU][(l * 2 + 0) * 1280 + col], mu1 = P.in[I_MU][(l * 2 + 1) * 1280 + col];
                const bf16_t* pc = Pb + (size_t)m0 * 2336 + col;
                float prev = (t0 > 0) ? bf2f(pc[-2336]) : 0.f, cur = bf2f(pc[0]);
#pragma unroll 4
                for (int i = 0; i < 16; ++i) {
                    const float nxt = (t0 + i + 1 < T) ? bf2f(pc[(size_t)(i + 1) * 2336]) : 0.f;
                    float v = cur + mu0 * (prev - cur) + mu1 * (nxt - cur);
                    if (cc < 64) v = tanhf(v); else if (cc >= 128) v = 1.f / (1.f + expf(-v));
                    lin[(d * 16 + i) * 256 + cc] = v; prev = cur; cur = nxt;
                }
            }
            __syncthreads();
            {
                const int n = tid & 255, i0 = (tid >> 8) * 8;
#pragma unroll 1
                for (int d = 0; d < 2; ++d) {
                    float aw[8], aa[8], ag[8];
#pragma unroll
                    for (int i = 0; i < 8; ++i) { aw[i] = 0.f; aa[i] = 0.f; ag[i] = 0.f; }
                    const float* wup = P.in[I_WUP] + (size_t)(l * 2 + d) * 64 * 256 + n; const float* aup = P.in[I_AUP] + (size_t)(l * 2 + d) * 64 * 256 + n;
                    const float* gup = P.in[I_GUP] + (size_t)(l * 2 + d) * 128 * 256 + n;
                    const LAS float* lb = lin + (d * 16 + i0) * 256;
#pragma unroll 1
                    for (int j = 0; j < 64; j += 4) {
                        const float w0 = wup[j * 256], w1 = wup[(j + 1) * 256], w2 = wup[(j + 2) * 256], w3 = wup[(j + 3) * 256];
                        const float a0 = aup[j * 256], a1 = aup[(j + 1) * 256], a2 = aup[(j + 2) * 256], a3 = aup[(j + 3) * 256];
#pragma unroll
                        for (int i = 0; i < 8; ++i) { const f32x4 x = *(const LAS f32x4*)(lb + i * 256 + j), y = *(const LAS f32x4*)(lb + i * 256 + 64 + j);
                            aw[i] += x[0] * w0 + x[1] * w1 + x[2] * w2 + x[3] * w3; aa[i] += y[0] * a0 + y[1] * a1 + y[2] * a2 + y[3] * a3; }
                    }
#pragma unroll 1
                    for (int j = 0; j < 128; j += 4) {
                        const float g0 = gup[j * 256], g1 = gup[(j + 1) * 256], g2 = gup[(j + 2) * 256], g3 = gup[(j + 3) * 256];
#pragma unroll
                        for (int i = 0; i < 8; ++i) { const f32x4 x = *(const LAS f32x4*)(lb + i * 256 + 128 + j); ag[i] += x[0] * g0 + x[1] * g1 + x[2] * g2 + x[3] * g3; }
                    }
                    const float w0v = P.in[I_W0][(l * 2 + d) * 256 + n], a0v = P.in[I_A0][(l * 2 + d) * 256 + n];
#pragma unroll
                    for (int i = 0; i < 8; ++i) { bf16_t* o = EAG + ((size_t)d * MTOK + m0 + i0 + i) * 768 + n;
                        o[0] = f2bf(0.60653065971f / (1.f + expf(-(w0v + aw[i])))); o[256] = f2bf(1.f / (1.f + expf(-(a0v + aa[i])))); o[512] = f2bf(ag[i]); }
                }
            }
            {
                const int n = tid & 127, d = (tid >> 7) & 1, i0 = (tid >> 8) * 8;
                const float* gau = P.in[I_GAUP] + (size_t)(l * 2 + d) * 16 * 128 + n; const float bb = P.in[I_GAB][(l * 2 + d) * 128 + n];
                float up[16];
#pragma unroll
                for (int j = 0; j < 16; ++j) up[j] = gau[j * 128];
#pragma unroll 2
                for (int i = 0; i < 8; ++i) { const bf16_t* ad = Pb + (size_t)(m0 + i0 + i) * 2336 + 1280 + 512 + 272 * d; float x = bb;
#pragma unroll
                    for (int j = 0; j < 16; ++j) x += bf2f(ad[j]) * up[j];
                    const float ls = (x >= 0.f) ? -log1pf(expf(-x)) : x - log1pf(expf(x));
                    GLA[((size_t)d * MTOK + m0 + i0 + i) * 128 + n] = ls * (1.f / 16.f); }
            }
            __syncthreads();
        } else {
            const int v = u - 1280, b = v >> 5, j0 = (v & 31) * 16, ch = tid;
            const float* ck = P.in[I_CK] + ((size_t)(b * 2 + l) * 512 + j0) * 512 + ch; const float* cv = P.in[I_CV] + ((size_t)(b * 2 + l) * 512 + j0) * 512 + ch;
            bf16_t* Kb = (bf16_t*)(P.ws + WS_K) + ((size_t)(MCTX + b * 2560 + 2048 + j0)) * 512 + ch;
            float vv[16];
#pragma unroll
            for (int i = 0; i < 16; ++i) { Kb[(size_t)i * 512] = f2bf(ck[(size_t)i * 512]); vv[i] = cv[(size_t)i * 512]; }
            u32x4 w0, w1; w0.x = cvt_pk_bf16(vv[0], vv[1]); w0.y = cvt_pk_bf16(vv[2], vv[3]); w0.z = cvt_pk_bf16(vv[4], vv[5]); w0.w = cvt_pk_bf16(vv[6], vv[7]);
            w1.x = cvt_pk_bf16(vv[8], vv[9]); w1.y = cvt_pk_bf16(vv[10], vv[11]); w1.z = cvt_pk_bf16(vv[12], vv[13]); w1.w = cvt_pk_bf16(vv[14], vv[15]);
            bf16_t* vt = (bf16_t*)(P.ws + WS_VT) + VT_LAT_OFF + ((size_t)(b * 512 + ch)) * 2560 + 2048 + j0;
            *(u32x4*)vt = w0; *(u32x4*)(vt + 8) = w1;
        }
    }
}

#define FMAC_BC(acc, vec, s, I) asm volatile("v_fmac_f32_dpp %0, %1, %2 row_newbcast:" #I " row_mask:0xf bank_mask:0xf" : "+v"(acc) : "v"(vec), "v"(s))
#define MUL_BC(dst, vec, s, I) asm volatile("v_mul_f32_dpp %0, %1, %2 row_newbcast:" #I " row_mask:0xf bank_mask:0xf" : "=v"(dst) : "v"(vec), "v"(s))
#define REP16(X) X(0) X(1) X(2) X(3) X(4) X(5) X(6) X(7) X(8) X(9) X(10) X(11) X(12) X(13) X(14) X(15)

__device__ void rwkv_block(PR P, int l, int role  , LAS float* lf) {
    const int tid = ltid(), lane = tid & 63, w = tid >> 6, si = w >> 2, rg = w & 3;
    const bool lat = role < 32; const int s = lat ? role * 2 + si : (role - 32) * 2 + si;
    const int b = s >> 3, h = (s >> 1) & 3, d = s & 1, T = lat ? 2048 : 256;
    const int mbase = lat ? MCTX + b * 2048 : b * 256;
    LAS float* vec = lf;
    LAS float* post = lf + 2 * 16 * 6 * 64;
    LAS float* ybuf = post + 2 * 16 * 2 * 64;
    const bf16_t* Pb = (const bf16_t*)(P.ws + WS_P); const bf16_t* EAG = (const bf16_t*)(P.ws + WS_EAG) + (size_t)d * MTOK * 768;
    bf16_t* MX = (bf16_t*)(P.ws + WS_H);
    const int ch = h * 64 + lane;
    const float mu0r = P.in[I_MU][(l * 2) * 1280 + ch], mu1r = P.in[I_MU][(l * 2 + 1) * 1280 + ch];
    const float mu0k = P.in[I_MU][(l * 2) * 1280 + 256 + ch], mu1k = P.in[I_MU][(l * 2 + 1) * 1280 + 256 + ch];
    const float mu0v = P.in[I_MU][(l * 2) * 1280 + 512 + ch], mu1v = P.in[I_MU][(l * 2 + 1) * 1280 + 512 + ch];
    const float kkc = P.in[I_KK][l * 256 + ch], kac = P.in[I_KA][l * 256 + ch], rkc = P.in[I_RK][(l * 2 + d) * 256 + ch];
    const float gng = P.in[I_GNG][(l * 2 + d) * 256 + ch], gnb = P.in[I_GNB][(l * 2 + d) * 256 + ch];
    const int r16 = lane & 15, cb = lane >> 4, row = rg * 16 + r16;
    float S[16];
    if (lat) { const float* s0 = P.in[I_SRW] + ((((size_t)(b * 2 + l) * 2 + d) * 4 + h) * 64 + row) * 64 + cb * 16;
#pragma unroll
        for (int i = 0; i < 16; ++i) S[i] = s0[i]; }
    else {
#pragma unroll
        for (int i = 0; i < 16; ++i) S[i] = 0.f; }
    const int nch = T / 16;
#pragma unroll 1
    for (int c = 0; c < nch; ++c) {
#pragma unroll 1
        for (int i = 0; i < 4; ++i) {
            const int step = (w & 3) * 4 + i; const int q = c * 16 + step, tt = d ? T - 1 - q : q; const int m = mbase + tt;
            const bf16_t* pr = Pb + (size_t)m * 2336 + ch;
            const bool hp = tt > 0, hn = tt + 1 < T;
            const float r0 = bf2f(pr[0]), k0 = bf2f(pr[256]), v0 = bf2f(pr[512]);
            const float rp = hp ? bf2f(pr[-2336]) : 0.f, kp = hp ? bf2f(pr[256 - 2336]) : 0.f, vp = hp ? bf2f(pr[512 - 2336]) : 0.f;
            const float rn = hn ? bf2f(pr[2336]) : 0.f, kn = hn ? bf2f(pr[256 + 2336]) : 0.f, vn = hn ? bf2f(pr[512 + 2336]) : 0.f;
            const bf16_t* eg = EAG + (size_t)m * 768 + ch;
            const float e = bf2f(eg[0]), a = bf2f(eg[256]), g = bf2f(eg[512]);
            const float r = r0 + mu0r * (rp - r0) + mu1r * (rn - r0), k = k0 + mu0k * (kp - k0) + mu1k * (kn - k0), v = v0 + mu0v * (vp - v0) + mu1v * (vn - v0);
            const float kkv = k * kkc; const float nrm = sqrtf(wave_sum(kkv * kkv)); const float kk = kkv / fmaxf(nrm, 1e-12f);
            const float kd = k * (1.f + (a - 1.f) * kac);
            const float bonus = wave_sum(r * kd * rkc);
            LAS float* vp_ = vec + ((si * 16 + step) * 6) * 64 + lane;
            vp_[0] = expf(-e); vp_[64] = kk; vp_[128] = kk * a; vp_[192] = kd; vp_[256] = r; vp_[320] = v;
            LAS float* pp = post + ((si * 16 + step) * 2) * 64 + lane; pp[0] = g; pp[64] = bonus * v;
        }
        __syncthreads();
#pragma unroll 1
        for (int step = 0; step < 16; ++step) {
            const LAS float* vp_ = vec + ((si * 16 + step) * 6) * 64;
            const float vw = vp_[lane], vkk = vp_[64 + lane], vkka = vp_[128 + lane], vkd = vp_[192 + lane], vr = vp_[256 + lane], vrow = vp_[320 + row];
            float sa0 = 0.f, sa1 = 0.f;
            asm volatile("s_nop 1");
#define SA_STEP(I) if ((I) & 1) FMAC_BC(sa1, vkk, S[I], I); else FMAC_BC(sa0, vkk, S[I], I);
            REP16(SA_STEP)
            float sa = sa0 + sa1; sa += __shfl_xor(sa, 16); sa += __shfl_xor(sa, 32);
            const float nsa = -sa;
            float y0 = 0.f, y1 = 0.f;
            asm volatile("s_nop 1");
#define UP_STEP(I) MUL_BC(S[I], vw, S[I], I); FMAC_BC(S[I], vkka, nsa, I); FMAC_BC(S[I], vkd, vrow, I); if ((I) & 1) FMAC_BC(y1, vr, S[I], I); else FMAC_BC(y0, vr, S[I], I);
            REP16(UP_STEP)
            float y = y0 + y1; y += __shfl_xor(y, 16); y += __shfl_xor(y, 32);
            if (cb == 0) ybuf[(si * 16 + step) * 64 + row] = y;
        }
        __syncthreads();
#pragma unroll 1
        for (int i = 0; i < 4; ++i) {
            const int step = (w & 3) * 4 + i; const int q = c * 16 + step, tt = d ? T - 1 - q : q; const int m = mbase + tt;
            const float y = ybuf[(si * 16 + step) * 64 + lane];
            const float mu = wave_sum(y) * (1.f / 64.f); const float dv = y - mu; const float var = wave_sum(dv * dv) * (1.f / 64.f);
            const LAS float* pp = post + ((si * 16 + step) * 2) * 64 + lane;
            const float o = (dv * (1.0f / sqrtf(var + 64e-5f)) * gng + gnb + pp[64]) * pp[0];
            MX[(size_t)m * 1536 + d * 256 + ch] = f2bf(o);
        }
    }
    if (!lat) { float* so = P.out + O_NRW + ((((size_t)(b * 2 + l) * 2 + d) * 4 + h) * 64 + row) * 64 + cb * 16;
#pragma unroll
        for (int i = 0; i < 16; ++i) so[i] = S[i]; }
    __syncthreads();
}
__device__ void gla_wave(PR P, int l, int s, bool lat, LAS float* wl  ) {
    const int lane = ltid() & 63;
    const int b = s >> 3, h = (s >> 1) & 3, d = s & 1, T = lat ? 2048 : 256;
    const int mbase = lat ? MCTX + b * 2048 : b * 256;
    LAS float* qb = wl; LAS float* kb = wl + 512; LAS float* ab = wl + 1024; LAS float* vb = wl + 1536; LAS float* gb = wl + 2560;
    const bf16_t* Pb = (const bf16_t*)(P.ws + WS_P) + 1280; const float* GLA = (const float*)(P.ws + WS_GLA) + (size_t)d * MTOK * 128;
    bf16_t* MX = (bf16_t*)(P.ws + WS_H);
    const float gn = P.in[I_GGN][l * 64 + lane];
    float S[32];
    if (lat) { const float* s0 = P.in[I_SGLA] + ((((size_t)(b * 2 + l) * 2 + d) * 4 + h) * 32) * 64 + lane;
#pragma unroll
        for (int k = 0; k < 32; ++k) S[k] = s0[k * 64]; }
    else {
#pragma unroll
        for (int k = 0; k < 32; ++k) S[k] = 0.f; }
    const int nch = T / 16, l15 = lane & 15;
#pragma unroll 1
    for (int c = 0; c < nch; ++c) {
        __builtin_amdgcn_wave_barrier();
#pragma unroll
        for (int jj = 0; jj < 8; ++jj) { const int idx = lane + 64 * jj, step = idx >> 5, kq = idx & 31; const int q = c * 16 + step, tt = d ? T - 1 - q : q; const size_t m = (size_t)(mbase + tt);
            qb[idx] = bf2f(Pb[m * 2336 + h * 32 + kq]) * 0.17677669529f; kb[idx] = bf2f(Pb[m * 2336 + 128 + h * 32 + kq]); ab[idx] = expf(GLA[m * 128 + h * 32 + kq]); }
#pragma unroll
        for (int step = 0; step < 16; ++step) { const int q = c * 16 + step, tt = d ? T - 1 - q : q; const size_t m = (size_t)(mbase + tt);
            vb[step * 64 + lane] = bf2f(Pb[m * 2336 + 256 + h * 64 + lane]); gb[step * 64 + lane] = bf2f(Pb[m * 2336 + 512 + 272 * d + 16 + h * 64 + lane]); }
        asm volatile("s_waitcnt lgkmcnt(0)" ::: "memory");
        __builtin_amdgcn_wave_barrier();
        float o[16];
#pragma unroll
        for (int step = 0; step < 16; ++step) {
            const float qlo = qb[step * 32 + l15], qhi = qb[step * 32 + 16 + l15], klo = kb[step * 32 + l15], khi = kb[step * 32 + 16 + l15], alo = ab[step * 32 + l15], ahi = ab[step * 32 + 16 + l15];
            const float v = vb[step * 64 + lane];
            float o0 = 0.f, o1 = 0.f;
            asm volatile("s_nop 1");
#define GLA_LO(I) MUL_BC(S[I], alo, S[I], I); FMAC_BC(S[I], klo, v, I); FMAC_BC(o0, qlo, S[I], I);
#define GLA_HI(I) MUL_BC(S[16 + I], ahi, S[16 + I], I); FMAC_BC(S[16 + I], khi, v, I); FMAC_BC(o1, qhi, S[16 + I], I);
            REP16(GLA_LO)
            REP16(GLA_HI)
            o[step] = o0 + o1;
        }
#pragma unroll
        for (int step = 0; step < 16; ++step) { const int q = c * 16 + step, tt = d ? T - 1 - q : q; const size_t m = (size_t)(mbase + tt);
            const float ss = wave_sum(o[step] * o[step]) * (1.f / 64.f); const float gd = gb[step * 64 + lane];
            const float r = o[step] * (1.0f / sqrtf(ss + 1e-6f)) * gn * (gd / (1.f + expf(-gd)));
            MX[m * 1536 + 512 + d * 256 + h * 64 + lane] = f2bf(r); }
    }
    if (!lat) { float* so = P.out + O_NGLA + ((((size_t)(b * 2 + l) * 2 + d) * 4 + h) * 32) * 64 + lane;
#pragma unroll
        for (int k = 0; k < 32; ++k) so[k * 64] = S[k]; }
}

typedef float f32x16 __attribute__((ext_vector_type(16)));
__device__ void attn_item(PR P, int l, int it, float lam, float lam_init) {
    const int lane = ltid() & 63, q32 = lane & 31, hh = lane >> 5;
    int b, h, qt, Tk, m0; size_t krow0, vbase;
    if (it < 2048) { b = it >> 8; h = (it >> 6) & 3; qt = it & 63; Tk = 2560; m0 = MCTX + b * 2048 + qt * 32; krow0 = (size_t)MCTX + (size_t)b * 2560; vbase = VT_LAT_OFF + ((size_t)(b * 512 + h * 128)) * 2560; }
    else { const int i2 = it - 2048; b = i2 >> 5; h = (i2 >> 3) & 3; qt = i2 & 7; Tk = 256; m0 = b * 256 + qt * 32; krow0 = (size_t)b * 256; vbase = ((size_t)(b * 512 + h * 128)) * 256; }
    const bf16_t* Qp = (const bf16_t*)(P.ws + WS_Q) + (size_t)(m0 + q32) * 512 + h * 128 + 8 * hh;
    const int pi = ((q32 & 7) < 4) ? ((q32 >> 3) * 4 + (q32 & 3)) : (16 + (q32 >> 3) * 4 + (q32 & 3));
    const bf16_t* Kp = (const bf16_t*)(P.ws + WS_K) + (krow0 + pi) * 512 + h * 128 + 8 * hh;
    const bf16_t* Vp = (const bf16_t*)(P.ws + WS_VT) + vbase + (size_t)q32 * Tk + 16 * hh;
    f32x16 O[2][4];
#pragma unroll
    for (int c = 0; c < 2; ++c)
#pragma unroll
        for (int eb = 0; eb < 4; ++eb)
#pragma unroll
            for (int i = 0; i < 16; ++i) O[c][eb][i] = 0.f;
    float mrun[2] = {-1e30f, -1e30f}, lrun[2] = {0.f, 0.f};
#pragma unroll 1
    for (int key0 = 0; key0 < Tk; key0 += 32) {
        const bf16_t* kt = Kp + (size_t)key0 * 512; const bf16_t* vt = Vp + key0;
#pragma unroll
        for (int c = 0; c < 2; ++c) {
            f32x16 sc;
#pragma unroll
            for (int i = 0; i < 16; ++i) sc[i] = 0.f;
#pragma unroll
            for (int j = 0; j < 4; ++j) { const bf16x8 kf = *(const bf16x8*)(kt + c * 64 + j * 16); const bf16x8 qf = *(const bf16x8*)(Qp + c * 64 + j * 16);
                sc = __builtin_amdgcn_mfma_f32_32x32x16_bf16(kf, qf, sc, 0, 0, 0); }
            float mx = sc[0];
#pragma unroll
            for (int i = 1; i < 16; ++i) mx = fmaxf(mx, sc[i]);
            mx = fmaxf(mx, __shfl_xor(mx, 32));
            const float mnew = fmaxf(mrun[c], mx); const float alpha = __expf(mrun[c] - mnew); mrun[c] = mnew;
            float p[16]; float rs = 0.f;
#pragma unroll
            for (int i = 0; i < 16; ++i) { p[i] = __expf(sc[i] - mnew); rs += p[i]; }
            rs += __shfl_xor(rs, 32);
            lrun[c] = lrun[c] * alpha + rs;
            bf16x8 pf[2];
#pragma unroll
            for (int mm = 0; mm < 2; ++mm) { u32x4 w;
                asm volatile("v_cvt_pk_bf16_f32 %0, %4, %5\n\tv_cvt_pk_bf16_f32 %1, %6, %7\n\tv_cvt_pk_bf16_f32 %2, %8, %9\n\tv_cvt_pk_bf16_f32 %3, %10, %11\n\ts_nop 1"
                             : "=&v"(w[0]), "=&v"(w[1]), "=&v"(w[2]), "=&v"(w[3])
                             : "v"(p[8 * mm]), "v"(p[8 * mm + 1]), "v"(p[8 * mm + 2]), "v"(p[8 * mm + 3]), "v"(p[8 * mm + 4]), "v"(p[8 * mm + 5]), "v"(p[8 * mm + 6]), "v"(p[8 * mm + 7]));
                pf[mm] = __builtin_bit_cast(bf16x8, w); }
#pragma unroll
            for (int eb = 0; eb < 4; ++eb) {
#pragma unroll
                for (int i = 0; i < 16; ++i) O[c][eb][i] *= alpha;
#pragma unroll
                for (int mm = 0; mm < 2; ++mm) { const bf16x8 vf = *(const bf16x8*)(vt + (size_t)(eb * 32) * Tk + 8 * mm); O[c][eb] = __builtin_amdgcn_mfma_f32_32x32x16_bf16(vf, pf[mm], O[c][eb], 0, 0, 0); }
            }
        }
    }
    const float i1 = 1.f / lrun[0], i2 = lam / lrun[1];
    float ss = 0.f;
#pragma unroll
    for (int eb = 0; eb < 4; ++eb)
#pragma unroll
        for (int i = 0; i < 16; ++i) { const float o = O[0][eb][i] * i1 - O[1][eb][i] * i2; O[0][eb][i] = o; ss += o * o; }
    ss += __shfl_xor(ss, 32);
    const float rn = (1.0f / sqrtf(ss * (1.f / 128.f) + 1e-6f)) * (1.f - lam_init);
    bf16_t* op = (bf16_t*)(P.ws + WS_H) + (size_t)(m0 + q32) * 1536 + 1024 + h * 128;
    const float* gn = P.in[I_DGN] + l * 128;
#pragma unroll
    for (int eb = 0; eb < 4; ++eb)
#pragma unroll
        for (int i4 = 0; i4 < 4; ++i4) { const int e = eb * 32 + i4 * 8 + 4 * hh; const f32x4 g = *(const f32x4*)(gn + e);
            u32x2 w; w.x = cvt_pk_bf16(O[0][eb][i4 * 4] * rn * g[0], O[0][eb][i4 * 4 + 1] * rn * g[1]); w.y = cvt_pk_bf16(O[0][eb][i4 * 4 + 2] * rn * g[2], O[0][eb][i4 * 4 + 3] * rn * g[3]);
            *(u32x2*)(op + e) = w; }
}

__device__ void mixer_phase(PR P, int l, LAS unsigned char* lds) {
    const int lane = ltid() & 63, w = ltid() >> 6;
    for (int role = lbid(); role < 120; role += gridDim.x) {
        if (role < 32) rwkv_block(P, l, role, (LAS float*)lds);
        else if (role < 40) gla_wave(P, l, (role - 32) * 8 + w, true, (LAS float*)lds + w * 3584);
        else if (role < 104) rwkv_block(P, l, role - 40 + 32, (LAS float*)lds);
        else gla_wave(P, l, (role - 104) * 8 + w, false, (LAS float*)lds + w * 3584);
    }
    const float* lp = P.in[I_LAM] + l * 256;
    const float s1 = wave_sum(lp[lane] * lp[64 + lane]), s2 = wave_sum(lp[128 + lane] * lp[192 + lane]);
    const float lam_init = (l == 0) ? 0.2f : 0.35550906759f;
    const float lam = expf(s1) - expf(s2) + lam_init;
    unsigned* ctr = (unsigned*)(P.ws + WS_CTL) + l;
    for (;;) {
        unsigned it = 0;
        if (lane == 0) it = atomicAdd(ctr, 1u);
        it = (unsigned)__builtin_amdgcn_readfirstlane((int)it);
        if (it >= 2560u) break;
        attn_item(P, l, (int)it, lam, lam_init);
    }
}
__device__ __forceinline__ void run_gemm_ffn_up(PR P, LAS unsigned char* lds, int f) {
    Gemm g{(const bf16_t*)(P.ws + WS_H), (const bf16_t*)(P.ws + WS_WGU) + (size_t)f * 5632 * 1024, MTOK, 5632, 1024};
    StaticOrder S; S.init(g.M, g.N, (int)gridDim.x, (int)blockIdx.x);
    EpiAct E{(bf16_t*)(P.ws + WS_ACT)};
    gemm_phase<EpiAct, StaticOrder, false>(lds, g, S, E, nullptr);
}
__device__ __forceinline__ void run_gemm_res(PR P, LAS unsigned char* lds, const bf16_t* A, const bf16_t* Bt, int K, const float* xp, const float* xs, int l, int gidx, float gs) {
    Gemm g{A, Bt, MTOK, 1024, K};
    StaticOrder S; S.init(g.M, g.N, (int)gridDim.x, (int)blockIdx.x);
    EpiRes E{xp, xs, P.out, (const float*)(P.ws + WS_COND) + (size_t)l * 9 * 9216, gidx, gs};
    gemm_phase<EpiRes, StaticOrder, false>(lds, g, S, E, nullptr);
}
__device__ __forceinline__ void run_gemm_in(PR P, LAS unsigned char* lds, int l) {
    { Gemm g{(const bf16_t*)(P.ws + WS_H), (const bf16_t*)(P.ws + WS_WIN), MTOK, 3584, 1024};
      StaticOrder S; S.init(g.M, g.N, (int)gridDim.x, (int)blockIdx.x);
      EpiIn E{(bf16_t*)(P.ws + WS_Q), (bf16_t*)(P.ws + WS_K), (bf16_t*)(P.ws + WS_P), P.out + O_NK + (size_t)l * 256 * 512};
      gemm_phase<EpiIn, StaticOrder, false>(lds, g, S, E, nullptr); }
    { Gemm g{(const bf16_t*)(P.ws + WS_WIN) + (size_t)3584 * 1024, (const bf16_t*)(P.ws + WS_H), 512, MTOK, 1024};
      const int G = (int)gridDim.x; StaticOrder S; S.init(g.M, g.N, G, (int)((blockIdx.x + G - (1120 % G)) % G));
      EpiVt E{(bf16_t*)(P.ws + WS_VT), P.out + O_NV + (size_t)l * 256 * 512};
      gemm_phase<EpiVt, StaticOrder, false>(lds, g, S, E, nullptr); }
}

__global__ void __launch_bounds__(512, 2) mega(Params Pk) {
    extern __shared__ __attribute__((aligned(16))) unsigned char smem[];
    LAS unsigned char* lds = (LAS unsigned char*)smem;
    cg::grid_group grid = cg::this_grid();
    if (threadIdx.x < 35) ((LAS unsigned long long*)(lds + 131072))[threadIdx.x] = ((const __attribute__((address_space(4))) unsigned long long*)__builtin_amdgcn_kernarg_segment_ptr())[threadIdx.x];
    __syncthreads();
    PR P = *(const LAS Params*)(lds + 131072);
    if (blockIdx.x == 0 && threadIdx.x < 64) ((unsigned*)(P.ws + WS_CTL))[threadIdx.x] = 0u;
    convert_weights(P, 0, (LAS float*)lds);
    cond_phase(P, (LAS float*)lds);
    grid.sync();
    mod_phase0(P);
    grid.sync();
#pragma unroll 1
    for (int l = 0; l < 2; ++l) {
        const float* xp = l == 0 ? P.in[I_XP] : P.out; const float* xs = l == 0 ? P.in[I_XS] : P.out + (size_t)MCTX * 1024;
        run_gemm_ffn_up(P, lds, 0);
        grid.sync();
        run_gemm_res(P, lds, (const bf16_t*)(P.ws + WS_ACT), (const bf16_t*)(P.ws + WS_WD), 2816, xp, xs, l, 2, 0.5f);
        grid.sync();
        ln_phase(P, l, 0, 3, l);
        grid.sync();
        run_gemm_in(P, lds, l);
        grid.sync();
        prep_phase(P, l, (LAS float*)lds);
        grid.sync();
        mixer_phase(P, l, lds);
        grid.sync();
        run_gemm_res(P, lds, (const bf16_t*)(P.ws + WS_H), (const bf16_t*)(P.ws + WS_WOUT), 1536, P.out, P.out + (size_t)MCTX * 1024, l, 5, 1.0f);
        grid.sync();
        ln_phase(P, l, 1, 6, l);
        grid.sync();
        run_gemm_ffn_up(P, lds, 1);
        grid.sync();
        run_gemm_res(P, lds, (const bf16_t*)(P.ws + WS_ACT), (const bf16_t*)(P.ws + WS_WD) + (size_t)1024 * 2816, 2816, P.out, P.out + (size_t)MCTX * 1024, l, 8, 0.5f);
        grid.sync();
        ln_phase(P, l, 2, l == 0 ? 0 : -1, l + 1);
        if (l == 0) convert_weights(P, 1, (LAS float*)lds);
        grid.sync();
    }
}
extern "C" void kernel_launch(void* const* d_in, const int* in_sizes, int n_in, void* d_out, int out_size, void* d_ws, size_t ws_size, hipStream_t stream) {
    constexpr size_t kDynLds = 131072 + 512;
    static int grid_blocks = 0;
    if (!grid_blocks) {
        int dev = 0, cus = 0, per_cu = 0;
        hipGetDevice(&dev);
        hipDeviceGetAttribute(&cus, hipDeviceAttributeMultiprocessorCount, dev);
        hipFuncSetAttribute((const void*)mega, hipFuncAttributeMaxDynamicSharedMemorySize, (int)kDynLds);
        hipOccupancyMaxActiveBlocksPerMultiprocessor(&per_cu, (const void*)mega, 512, kDynLds);
        if (per_cu < 1) { fprintf(stderr, "occupancy query says %d blocks/CU\n", per_cu); per_cu = 1; }
        if (per_cu > 1) per_cu = 1;
        grid_blocks = cus * per_cu;
        if (ws_size < WS_END) fprintf(stderr, "workspace too small: %zu < %zu\n", ws_size, (size_t)WS_END);
    }
    Params p{};
    for (int i = 0; i < 33; ++i) p.in[i] = (const float*)d_in[i];
    p.out = (float*)d_out; p.ws = (unsigned char*)d_ws;
    void* args[] = {&p};
    hipError_t e = hipLaunchCooperativeKernel((const void*)mega, dim3(grid_blocks), dim3(512), args, kDynLds, stream);
    if (e != hipSuccess) fprintf(stderr, "cooperative launch failed: %s (grid %d)\n", hipGetErrorString(e), grid_blocks);
}
```

```cpp
#include <hip/hip_runtime.h>
#include <hip/hip_cooperative_groups.h>
#include <cstdio>
namespace cg = cooperative_groups;
namespace pg8 {
#define PG8_LAS __attribute__((address_space(3)))
typedef unsigned short bf16_t;
typedef short bf16x8 __attribute__((ext_vector_type(8)));
typedef float f32x4 __attribute__((ext_vector_type(4)));
typedef unsigned u32x4 __attribute__((ext_vector_type(4)));
constexpr int BM = 256, BK = 64, HALF = 128, HTB = HALF * BK * 2  , STAGE_BYTES = 8 * HTB, NXCD = 8, WGM = 8;

__host__ __device__ __forceinline__ int lds_byte(int r, int c) { const int st = (r >> 4) * 2 + (c >> 5), rr = r & 15, cc = c & 31, ob = rr * 64 + cc * 2; return st * 1024 + (ob ^ (((ob >> 9) & 1) << 5)); }
__host__ __device__ __forceinline__ void stage_rc(int b, int& R, int& C) { const int st = b / 1024, sb = b % 1024, swz = sb ^ (((sb >> 9) & 1) << 5); R = (st >> 1) * 16 + swz / 64; C = (st & 1) * 32 + (swz % 64) / 2; }
__host__ __device__ __forceinline__ int perm32(int rho) { const int n = rho >> 4, i = rho & 15; return 8 * (i >> 2) + 4 * n + (i & 3); }

struct Unit { int pm, pn; };
struct Gemm { const bf16_t* A; const bf16_t* Bt; int M, N, K; };

struct StaticOrder {
    int nM, nN, nwg, G, c;
    __host__ __device__ void init(int M, int N, int G_, int c_) { nM = M / BM; nN = N / BM; nwg = nM * nN; G = G_; c = c_; }
    __host__ __device__ bool next(int i, Unit& u) const {
        const long L = (long)i * G + c; if (L >= nwg) return false;
        int wgid = (int)L; { const int q = nwg / NXCD, r = nwg % NXCD, xcd = wgid % NXCD, off = wgid / NXCD; wgid = (xcd < r ? xcd * (q + 1) : r * (q + 1) + (xcd - r) * q) + off; }
        const int nig = WGM * nN, gid = wgid / nig, fm = gid * WGM, gsz = (nM - fm) < WGM ? (nM - fm) : WGM;
        u.pm = fm + ((wgid % nig) % gsz); u.pn = (wgid % nig) / gsz; return true;
    }
    __device__ __forceinline__ void a_ready(const Unit&) const {}
    __device__ __forceinline__ void done(const Unit&) const {}
};
__device__ __forceinline__ unsigned cvt_pk_bf16(float lo, float hi) { unsigned r; asm volatile("v_cvt_pk_bf16_f32 %0, %1, %2" : "=v"(r) : "v"(lo), "v"(hi)); return r; }
typedef float f32x2 __attribute__((ext_vector_type(2)));
template <class Epi, class Sched, bool STAMP = false>
__device__ __forceinline__ void gemm_phase(PG8_LAS unsigned char* lds, const Gemm g, const Sched& S, const Epi& E, unsigned long long* stamps) {
    int tid_ = threadIdx.x; asm volatile("" : "+v"(tid_));
    const int tid = tid_, wid = __builtin_amdgcn_readfirstlane(tid >> 6), lane = tid & 63, wr = wid >> 2, wc = wid & 3, fr = lane & 15, fq = lane >> 4;
    const int K = g.K, nt = K / BK;
    int ts_lo = 0, ts_hi = 0, nts = 0; const unsigned long long rt_entry = STAMP ? (unsigned long long)wall_clock64() : 0ull;
#define PG8_STAMP() do { if (STAMP && wid == 0 && nts < 64) { const unsigned long long _c = (unsigned long long)clock64(); \
        ts_lo = (lane == nts) ? (int)(unsigned)_c : ts_lo; ts_hi = (lane == nts) ? (int)(unsigned)(_c >> 32) : ts_hi; ++nts; } } while (0)
    PG8_STAMP();
    unsigned voffA[2], voffB[2];
#pragma unroll
    for (int i = 0; i < 2; ++i) { int R, C; stage_rc(tid * 16 + i * 8192, R, C); const int Rb = Epi::PERM ? ((R & ~31) + perm32(R & 31)) : R;
        voffA[i] = (unsigned)(R * K + C) * 2u; voffB[i] = (unsigned)(Rb * K + C) * 2u; }
    const size_t kstep = (size_t)(BK * 2);
    const size_t hstep = (size_t)HALF * K * 2;
    const size_t tstep = 2 * hstep;
    const unsigned ldsw = (unsigned)wid * 1024u;
    const int aoff = lds_byte(wr * 64 + fr, fq * 8), boff = lds_byte(wc * 32 + fr, fq * 8);
#define PG8_SA(b, h) (((b) * 2 + (h)) * HTB)
#define PG8_SB(b, h) ((4 + (b) * 2 + (h)) * HTB)
#define PG8_STAGE(bufoff, gbase, voff) do { _Pragma("unroll") for (int _i = 0; _i < 2; ++_i) \
        __builtin_amdgcn_global_load_lds((const unsigned*)((const char*)(gbase) + (voff)[_i]), (PG8_LAS unsigned*)(lds + (bufoff) + ldsw + _i * 8192), 16, 0, 0); } while (0)
#define PG8_LDA(dst, b, h) do { _Pragma("unroll") for (int m = 0; m < 4; ++m) _Pragma("unroll") for (int k = 0; k < 2; ++k) dst[m][k] = *(const PG8_LAS bf16x8*)(lds + PG8_SA(b, h) + aoff + m * 2048 + k * 1024); } while (0)
#define PG8_LDB(dst, b, h) do { _Pragma("unroll") for (int n = 0; n < 2; ++n) _Pragma("unroll") for (int k = 0; k < 2; ++k) dst[n][k] = *(const PG8_LAS bf16x8*)(lds + PG8_SB(b, h) + boff + n * 2048 + k * 1024); } while (0)
#define PG8_MMA(ai, bj, At, Bt) do { __builtin_amdgcn_s_setprio(1); _Pragma("unroll") for (int m = 0; m < 4; ++m) _Pragma("unroll") for (int n = 0; n < 2; ++n) _Pragma("unroll") for (int k = 0; k < 2; ++k) \
        acc[ai][bj][m][n] = __builtin_amdgcn_mfma_f32_16x16x32_bf16(Bt[n][k], At[m][k], acc[ai][bj][m][n], 0, 0, 0); __builtin_amdgcn_s_setprio(0); } while (0)
#define PG8_WAIT_V(n) asm volatile("s_waitcnt vmcnt(" #n ")" ::: "memory")
#define PG8_WAIT_L(n) asm volatile("s_waitcnt lgkmcnt(" #n ")" ::: "memory")
#define PG8_BAR __builtin_amdgcn_s_barrier()
#define PG8_SCHED __builtin_amdgcn_sched_barrier(0)
    Unit cur, nxt; int ui = 0;
    if (!S.next(0, cur)) return;
    f32x4 acc[2][2][4][2];
#pragma unroll
    for (int a = 0; a < 2; ++a)
#pragma unroll
        for (int b = 0; b < 2; ++b)
#pragma unroll
            for (int m = 0; m < 4; ++m)
#pragma unroll
                for (int n = 0; n < 2; ++n) acc[a][b][m][n] = (f32x4){0.f, 0.f, 0.f, 0.f};
    bf16x8 At[4][2], B0[2][2], B1[2][2];
    const char* cA = (const char*)g.A + (size_t)cur.pm * tstep; const char* cB = (const char*)g.Bt + (size_t)cur.pn * tstep;
    S.a_ready(cur);
    PG8_STAGE(PG8_SB(0, 0), cB, voffB); PG8_STAGE(PG8_SA(0, 0), cA, voffA); PG8_STAGE(PG8_SB(0, 1), cB + hstep, voffB); PG8_STAGE(PG8_SA(0, 1), cA + hstep, voffA);
    if (wr == 1) PG8_BAR;
    PG8_WAIT_V(4); PG8_BAR;
    PG8_STAGE(PG8_SB(1, 0), cB + kstep, voffB); PG8_STAGE(PG8_SA(1, 0), cA + kstep, voffA); PG8_STAGE(PG8_SB(1, 1), cB + hstep + kstep, voffB);
    PG8_WAIT_V(6); PG8_BAR;
    PG8_STAMP();
    for (;;) {
        const bool has_next = S.next(ui + 1, nxt);
        const char* nA = has_next ? (const char*)g.A + (size_t)nxt.pm * tstep : cA; const char* nB = has_next ? (const char*)g.Bt + (size_t)nxt.pn * tstep : cB;
        for (int t = 0; t < nt; t += 2) {
            const bool last = (t == nt - 2);
            const char* a1 = cA + (size_t)(t + 1) * kstep;
            const char* a2 = last ? nA : cA + (size_t)(t + 2) * kstep; const char* b2 = last ? nB : cB + (size_t)(t + 2) * kstep;
            const char* a3 = a2 + kstep; const char* b3 = b2 + kstep;
            if (last && has_next) S.a_ready(nxt);
            PG8_LDB(B0, 0, 0); PG8_SCHED; PG8_LDA(At, 0, 0); PG8_STAGE(PG8_SA(1, 1), a1 + hstep, voffA);
            PG8_WAIT_L(8); PG8_BAR; PG8_WAIT_L(0); PG8_MMA(0, 0, At, B0); PG8_BAR; PG8_SCHED;
            PG8_LDB(B1, 0, 1); PG8_STAGE(PG8_SB(0, 0), b2, voffB);
            PG8_BAR; PG8_WAIT_L(0); PG8_MMA(0, 1, At, B1); PG8_BAR;
            PG8_LDA(At, 0, 1); PG8_STAGE(PG8_SA(0, 0), a2, voffA);
            PG8_BAR; PG8_WAIT_L(0); PG8_MMA(1, 0, At, B0); PG8_BAR; PG8_SCHED;
            PG8_STAGE(PG8_SB(0, 1), b2 + hstep, voffB);
            PG8_WAIT_V(6); PG8_BAR; PG8_MMA(1, 1, At, B1); PG8_BAR;
            PG8_LDB(B0, 1, 0); PG8_SCHED; PG8_LDA(At, 1, 0); PG8_STAGE(PG8_SA(0, 1), a2 + hstep, voffA);
            PG8_WAIT_L(8); PG8_BAR; PG8_WAIT_L(0); PG8_MMA(0, 0, At, B0); PG8_BAR; PG8_SCHED;
            PG8_LDB(B1, 1, 1); PG8_STAGE(PG8_SB(1, 0), b3, voffB);
            PG8_BAR; PG8_WAIT_L(0); PG8_MMA(0, 1, At, B1); PG8_BAR;
            PG8_LDA(At, 1, 1); PG8_STAGE(PG8_SA(1, 0), a3, voffA);
            PG8_BAR; PG8_WAIT_L(0); PG8_MMA(1, 0, At, B0); PG8_BAR; PG8_SCHED;
            PG8_STAGE(PG8_SB(1, 1), b3 + hstep, voffB);
            PG8_WAIT_V(6); PG8_BAR; PG8_MMA(1, 1, At, B1); PG8_BAR;
        }
        PG8_STAMP();
        if constexpr (!Epi::AFTER_DRAIN) { E(acc, cur, wr, wc, fr, fq); S.done(cur); }
        PG8_STAMP();
        if (!has_next) break;
#pragma unroll
        for (int a = 0; a < 2; ++a)
#pragma unroll
            for (int b = 0; b < 2; ++b)
#pragma unroll
                for (int m = 0; m < 4; ++m)
#pragma unroll
                    for (int n = 0; n < 2; ++n) acc[a][b][m][n] = (f32x4){0.f, 0.f, 0.f, 0.f};
        cur = nxt; cA = nA; cB = nB; ++ui;
    }
    PG8_WAIT_V(0);
    if (wr == 0) PG8_BAR;
    PG8_BAR;
    if constexpr (Epi::AFTER_DRAIN) { E.fused(acc, cur, wr, wc, fr, fq, lds, wid, lane); S.done(cur); }
    PG8_STAMP();
    if (STAMP && wid == 0) { stamps[lane] = lane < nts ? (((unsigned long long)(unsigned)ts_hi << 32) | (unsigned)ts_lo) : 0ull;
        if (lane == 62) stamps[62] = rt_entry; if (lane == 63) stamps[63] = (unsigned long long)wall_clock64(); }
#undef PG8_STAMP
#undef PG8_SA
#undef PG8_SB
#undef PG8_STAGE
#undef PG8_LDA
#undef PG8_LDB
#undef PG8_MMA
#undef PG8_WAIT_V
#undef PG8_WAIT_L
#undef PG8_BAR
#undef PG8_SCHED
}
}
#define LAS __attribute__((address_space(3)))
#include <cstdlib>
#include <vector>

#define XB_TMO      128
#define XB_XCNT(j)  (256  + 64 * (j))
#define XB_XSUB(j)  (1280 + 64 * (j))
#define XB_XGEN(j)  (2304 + 64 * (j))
#define XB_TOP      3328
#define XB_TOPGEN   3392
#define XCD_BAR_WORDS 3456
#define XB_SPIN_CAP (1u << 18)

__device__ __forceinline__ unsigned xb_ld(unsigned* p)              { return __hip_atomic_load(p, __ATOMIC_RELAXED, __HIP_MEMORY_SCOPE_AGENT); }
__device__ __forceinline__ unsigned xb_add(unsigned* p, unsigned v) { return __hip_atomic_fetch_add(p, v, __ATOMIC_RELAXED, __HIP_MEMORY_SCOPE_AGENT); }
__device__ __forceinline__ unsigned xb_xcc_id() { return (unsigned)__builtin_amdgcn_s_getreg((3 << 11) | 20) & 0xFu; }
#define XB_SPIN(cond, bar) do { unsigned _sp = 0; while (cond) { __builtin_amdgcn_s_sleep(1); \
    if ((++_sp & 255u) == 0u) { if (xb_ld(&(bar)[XB_TMO])) break; if (_sp > XB_SPIN_CAP) { atomicAdd(&(bar)[XB_TMO], 1u); break; } } } } while (0)

struct XcdBarrier {
    unsigned* bar; unsigned x;
    volatile LAS unsigned* st;
};

__device__ __forceinline__ XcdBarrier xcd_barrier_post(unsigned* bar, volatile LAS unsigned* st) {
    XcdBarrier b; b.bar = bar; b.x = xb_xcc_id(); b.st = st;
    if (threadIdx.x == 0) (void)xb_add(&bar[XB_XCNT(b.x)], 1u);
    return b;
}
__device__ __forceinline__ void xcd_barrier_complete(unsigned* bar, unsigned x, unsigned& nloc, unsigned& nx) {
    const unsigned G = gridDim.x * gridDim.y * gridDim.z;
    unsigned sum, cnt, mine, sp = 0u;
    for (;;) {
        sum = 0u; cnt = 0u; mine = 0u;
#pragma unroll
        for (unsigned j = 0; j < 16; ++j) { const unsigned c = xb_ld(&bar[XB_XCNT(j)]); sum += c; cnt += (c > 0u) ? 1u : 0u; mine = (j == x) ? c : mine; }
        if (sum == G) break;
        __builtin_amdgcn_s_sleep(1);
        if ((++sp & 255u) == 0u) { if (xb_ld(&bar[XB_TMO])) break; if (sp > XB_SPIN_CAP) { atomicAdd(&bar[XB_TMO], 1u); break; } }
    }
    nloc = mine > 0u ? mine : 1u; nx = cnt > 0u ? cnt : 1u;
}

__device__ __forceinline__ void xcd_barrier(const XcdBarrier& b) {
    asm volatile("s_waitcnt vmcnt(0)" ::: "memory");
    __syncthreads();
    if (threadIdx.x == 0) {
        unsigned* bar = b.bar;
        __builtin_amdgcn_s_waitcnt(0);
        unsigned nloc = b.st[0], nx = b.st[1];
        if (nloc == 0u) { xcd_barrier_complete(bar, b.x, nloc, nx); b.st[0] = nloc; b.st[1] = nx; }
        const unsigned old = xb_add(&bar[XB_XSUB(b.x)], 1u);
        const unsigned gen = old / nloc;
        if (old + 1u == (gen + 1u) * nloc) {
            __builtin_amdgcn_fence(__ATOMIC_RELEASE, "agent");
            asm volatile("s_waitcnt vmcnt(0)" ::: "memory");
            const unsigned og = xb_add(&bar[XB_TOP], 1u);
            const unsigned tg = og / nx;
            if (og + 1u == (tg + 1u) * nx) xb_add(&bar[XB_TOPGEN], 1u);
            else XB_SPIN(xb_ld(&bar[XB_TOPGEN]) == tg, bar);
            __builtin_amdgcn_fence(__ATOMIC_ACQUIRE, "agent");
            xb_add(&bar[XB_XGEN(b.x)], 1u);
            asm volatile("s_waitcnt vmcnt(0)" ::: "memory");
        } else {
            XB_SPIN(xb_ld(&bar[XB_XGEN(b.x)]) == gen, bar);
            __builtin_amdgcn_fence(__ATOMIC_ACQUIRE, "agent");
            asm volatile("s_waitcnt vmcnt(0)" ::: "memory");
        }
    }
    __syncthreads();
}

using namespace pg8;
#define LAS __attribute__((address_space(3)))
typedef unsigned u32x2 __attribute__((ext_vector_type(2)));

constexpr int MTOK = 20480, MCTX = 4096;
constexpr float ALPHA = 1.41421356237f;
constexpr float QSCALE = 0.125f * 1.44269504089f;
#define GAS __attribute__((address_space(1)))
struct ParamsH { const float* in[33]; float* out; unsigned char* ws; };
struct Params { const float* in[33]; float* out; unsigned char* ws; };
typedef const __attribute__((address_space(3))) Params& PR;
__device__ __forceinline__ const GAS float* gin(PR P, int i) { return (const GAS float*)P.in[i]; }
__device__ __forceinline__ GAS float* gout(PR P) { return (GAS float*)P.out; }
__device__ __forceinline__ GAS unsigned char* gws(PR P) { return (GAS unsigned char*)P.ws; }
enum { I_XP = 0, I_XS, I_SRW, I_SGLA, I_CK, I_CV, I_C, I_CCTX, I_WADA, I_BADA, I_LNG, I_LNB, I_WG, I_WU, I_WDN, I_WIN, I_WOUT,
       I_MU, I_KK, I_KA, I_W0, I_WUP, I_A0, I_AUP, I_GUP, I_RK, I_GNG, I_GNB, I_GAUP, I_GAB, I_GGN, I_LAM, I_DGN };
constexpr size_t O_Y = 0, O_NRW = 20971520, O_NGLA = 22020096, O_NK = 22544384, O_NV = 26738688;
constexpr size_t WS_CTL = 0;
constexpr size_t WS_XBAR = 1024;
constexpr size_t WS_COND = 16384;
constexpr size_t WS_WGU = WS_COND + 663552;
constexpr size_t WS_WD = WS_WGU + 2ull * 5632 * 1024 * 2;
constexpr size_t WS_WIN = WS_WD + 2ull * 1024 * 2816 * 2;
constexpr size_t WS_WOUT = WS_WIN + 4096ull * 1024 * 2;
constexpr size_t WS_WLORA = WS_WOUT + 1024ull * 1536 * 2;
constexpr size_t WS_H = WS_WLORA + 2ull * 768 * 256 * 2;
constexpr size_t WS_BIG = WS_H + 20480ull * 1536 * 2;
constexpr size_t WS_ACT = WS_BIG;
constexpr size_t WS_H3 = WS_BIG + 125829120;
constexpr size_t WS_P = WS_BIG;
constexpr size_t WS_Q = WS_P + 20480ull * 2336 * 2;
constexpr size_t WS_K = WS_Q + 20480ull * 512 * 2;
constexpr size_t WS_VT = WS_K + 24576ull * 512 * 2;
constexpr size_t WS_EAG = WS_VT + 24576ull * 512 * 2;
constexpr size_t WS_GLA = WS_EAG + 2ull * 20480 * 768 * 2;
constexpr size_t WS_END = WS_GLA + 2ull * 20480 * 128 * 4;
constexpr size_t VT_LAT_OFF = 16ull * 512 * 256;

__device__ __forceinline__ int ltid() { int t = threadIdx.x; asm volatile("" : "+v"(t)); return t; }
__device__ __forceinline__ int lbid() { int t = blockIdx.x; asm volatile("" : "+s"(t)); return t; }
__device__ __forceinline__ int condrow(int m) { return m < MCTX ? 0 : 1 + ((m - MCTX) >> 11); }
template <int CTRL> __device__ __forceinline__ float dppx(float x) { return __int_as_float(__builtin_amdgcn_update_dpp(0, __float_as_int(x), CTRL, 0xf, 0xf, false)); }
typedef unsigned u32v2 __attribute__((ext_vector_type(2)));
__device__ __forceinline__ float xrow_sum4(float x) {
    unsigned xi = __float_as_uint(x); u32v2 r = __builtin_amdgcn_permlane16_swap(xi, xi, false, false);
    const float s = __uint_as_float(r[0]) + __uint_as_float(r[1]);
    unsigned si = __float_as_uint(s); u32v2 q = __builtin_amdgcn_permlane32_swap(si, si, false, false);
    return __uint_as_float(q[0]) + __uint_as_float(q[1]);
}
__device__ __forceinline__ float xhalf_sum(float x) { unsigned xi = __float_as_uint(x); u32v2 q = __builtin_amdgcn_permlane32_swap(xi, xi, false, false); return __uint_as_float(q[0]) + __uint_as_float(q[1]); }
__device__ __forceinline__ float xhalf_max(float x) { unsigned xi = __float_as_uint(x); u32v2 q = __builtin_amdgcn_permlane32_swap(xi, xi, false, false); return fmaxf(__uint_as_float(q[0]), __uint_as_float(q[1])); }
__device__ __forceinline__ float wave_sum(float v) {
    v += dppx<0xB1>(v); v += dppx<0x4E>(v); v += dppx<0x141>(v); v += dppx<0x140>(v);
    return xrow_sum4(v);
}
__device__ __forceinline__ float bf2f(bf16_t b) { return __uint_as_float(((unsigned)b) << 16); }
__device__ __forceinline__ bf16_t f2bf(float f) { return (bf16_t)(cvt_pk_bf16(f, 0.f) & 0xffffu); }

__device__ __forceinline__ float wsrc(PR P, int l, int type, int f, int r, int k) {
    if (type == 0) { const int g = r >> 5, i = r & 31; const GAS float* src = (i < 16 ? gin(P, I_WG) : gin(P, I_WU)) + ((size_t)(l * 2 + f) * 1024 + k) * 2816; return src[16 * g + (i & 15)]; }
    if (type == 1) return gin(P, I_WDN)[((size_t)(l * 2 + f) * 2816 + k) * 1024 + r];
    if (type == 2) { int col; if (r < 512) col = 2336 + r; else if (r < 1024) col = 2848 + (r - 512); else if (r < 2304) col = r - 1024; else if (r < 3360) col = 1280 + (r - 2304); else if (r < 3584) return 0.f; else col = 3360 + (r - 3584);
        return gin(P, I_WIN)[((size_t)l * 1024 + k) * 3872 + col]; }
    if (type == 3) { const int kr = k < 512 ? (k & 255) : (k < 1024 ? 256 + ((k - 512) & 255) : k - 512);
        return gin(P, I_WOUT)[((size_t)l * 1024 + kr) * 1024 + r]; }
    const int d = r / 768, rr = r % 768, n = rr & 255;
    if (rr < 256) return k < 64 ? gin(P, I_WUP)[((size_t)(l * 2 + d) * 64 + k) * 256 + n] : 0.f;
    if (rr < 512) return (k >= 64 && k < 128) ? gin(P, I_AUP)[((size_t)(l * 2 + d) * 64 + (k - 64)) * 256 + n] : 0.f;
    return k >= 128 ? gin(P, I_GUP)[((size_t)(l * 2 + d) * 128 + (k - 128)) * 256 + n] : 0.f;
}
__device__ __forceinline__ void convert_weights(PR P, int l, LAS float* tile) {
    const int tid = ltid();
    for (int u = lbid(); u < 1432; u += gridDim.x) {
        int type, f = 0, rt, kt, K; GAS bf16_t* dst; int v = u;
        if (v < 704) { type = 0; f = v / 352; v %= 352; rt = v / 4; kt = v % 4; K = 1024; dst = (GAS bf16_t*)(gws(P) + WS_WGU) + (size_t)f * 5632 * 1024; }
        else if ((v -= 704) < 352) { type = 1; f = v / 176; v %= 176; rt = v / 11; kt = v % 11; K = 2816; dst = (GAS bf16_t*)(gws(P) + WS_WD) + (size_t)f * 1024 * 2816; }
        else if ((v -= 352) < 256) { type = 2; rt = v / 4; kt = v % 4; K = 1024; dst = (GAS bf16_t*)(gws(P) + WS_WIN); }
        else if ((v -= 256) < 96) { type = 3; rt = v / 6; kt = v % 6; K = 1536; dst = (GAS bf16_t*)(gws(P) + WS_WOUT); }
        else { v -= 96; type = 4; rt = v; kt = 0; K = 256; dst = (GAS bf16_t*)(gws(P) + WS_WLORA); }
        const int r0 = rt * 64, k0 = kt * 256;
        { const int rl = tid & 63, kb = tid >> 6; float val[32];
#pragma unroll
          for (int j = 0; j < 32; ++j) val[j] = wsrc(P, l, type, f, r0 + rl, k0 + kb + 8 * j);
#pragma unroll
          for (int j = 0; j < 32; ++j) tile[rl * 257 + kb + 8 * j] = val[j]; }
        __syncthreads();
        { const int rl = tid >> 3;
#pragma unroll
          for (int jj = 0; jj < 4; ++jj) { const int ks = (tid & 7) * 8 + jj * 64; const LAS float* t = tile + rl * 257 + ks;
            u32x4 w; w.x = cvt_pk_bf16(t[0], t[1]); w.y = cvt_pk_bf16(t[2], t[3]); w.z = cvt_pk_bf16(t[4], t[5]); w.w = cvt_pk_bf16(t[6], t[7]);
            *(GAS u32x4*)(dst + (size_t)(r0 + rl) * K + k0 + ks) = w; } }
        __syncthreads();
    }
}
__device__ __forceinline__ void cond_phase(PR P, LAS float* lf) {
    const int tid = ltid(), lane = tid & 63, w = tid >> 6;
    LAS float* sc = lf; LAS float* red = lf + 9 * 1024;
    for (int i = tid; i < 9 * 1024; i += 512) { const int j = i >> 10, k = i & 1023; const float c = (j == 0) ? gin(P, I_CCTX)[k] : gin(P, I_C)[(j - 1) * 1024 + k]; sc[i] = c / (1.f + expf(-c)); }
    __syncthreads();
    for (int u = lbid(); u < 288; u += gridDim.x) {
        const int l = u / 144, n0 = (u % 144) * 64;
        const GAS float* wa = gin(P, I_WADA) + (size_t)l * 1024 * 9216 + n0 + lane;
        float acc[9];
#pragma unroll
        for (int j = 0; j < 9; ++j) acc[j] = 0.f;
#pragma unroll 4
        for (int k = w * 128; k < w * 128 + 128; k += 4) {
            const float w0 = wa[(size_t)k * 9216], w1 = wa[(size_t)(k + 1) * 9216], w2 = wa[(size_t)(k + 2) * 9216], w3 = wa[(size_t)(k + 3) * 9216];
#pragma unroll
            for (int j = 0; j < 9; ++j) { const f32x4 s = *(const LAS f32x4*)(sc + j * 1024 + k); acc[j] += s.x * w0 + s.y * w1 + s.z * w2 + s.w * w3; }
        }
#pragma unroll
        for (int j = 0; j < 9; ++j) red[(w * 9 + j) * 64 + lane] = acc[j];
        __syncthreads();
        for (int i = tid; i < 576; i += 512) { const int j = i >> 6, ln = i & 63; float s = 0.f;
#pragma unroll
            for (int ww = 0; ww < 8; ++ww) s += red[(ww * 9 + j) * 64 + ln];
            ((GAS float*)(gws(P) + WS_COND))[((size_t)l * 9 + j) * 9216 + n0 + ln] = s + gin(P, I_BADA)[l * 9216 + n0 + ln]; }
        __syncthreads();
    }
}
__device__ __forceinline__ void mod_phase0(PR P) {
    GAS bf16_t* H = (GAS bf16_t*)(gws(P) + WS_H); const GAS float* cond = (const GAS float*)(gws(P) + WS_COND);
    const int lane = ltid() & 63, w = ltid() >> 6; const int stride = (int)gridDim.x * 8;
    for (int m0 = lbid() * 8 + w; m0 < MTOK; m0 += 2 * stride) {
        f32x4 xv[2][4];
#pragma unroll
        for (int r = 0; r < 2; ++r) { const int m = m0 + r * stride; if (m < MTOK) { const GAS float* x = ((m < MCTX) ? gin(P, I_XP) + (size_t)m * 1024 : gin(P, I_XS) + (size_t)(m - MCTX) * 1024) + lane * 4;
#pragma unroll
            for (int i = 0; i < 4; ++i) xv[r][i] = *(const GAS f32x4*)(x + i * 256); } }
#pragma unroll
        for (int r = 0; r < 2; ++r) { const int m = m0 + r * stride; if (m >= MTOK) continue;
            const GAS float* cr = cond + (size_t)condrow(m) * 9216 + lane * 4;
#pragma unroll
            for (int i = 0; i < 4; ++i) { const f32x4 sh = *(const GAS f32x4*)(cr + i * 256), sc = *(const GAS f32x4*)(cr + 1024 + i * 256); const f32x4 h = xv[r][i] * (1.f + sc) + sh;
                u32x2 wv; wv.x = cvt_pk_bf16(h[0], h[1]); wv.y = cvt_pk_bf16(h[2], h[3]); *(GAS u32x2*)(H + (size_t)m * 1024 + i * 256 + lane * 4) = wv; } }
    }
}
__device__ __forceinline__ void ln_phase(PR P, int l, int which, int nextmod, int lc, int row_lo, int row_hi, int nblk, int bidx) {
    GAS float* X = gout(P); GAS bf16_t* H = (GAS bf16_t*)(gws(P) + (which == 1 ? WS_H3 : WS_H));
    const GAS float* g = gin(P, I_LNG) + (l * 3 + which) * 1024; const GAS float* b = gin(P, I_LNB) + (l * 3 + which) * 1024;
    const GAS float* cond = (const GAS float*)(gws(P) + WS_COND) + (size_t)lc * 9 * 9216;
    const int lane = ltid() & 63, w = ltid() >> 6;
    for (int m = row_lo + bidx * 8 + w; m < row_hi; m += nblk * 8) {
        GAS float* xr = X + (size_t)m * 1024 + lane * 4;
        f32x4 v[4]; float s = 0.f;
#pragma unroll
        for (int i = 0; i < 4; ++i) { v[i] = *(const GAS f32x4*)(xr + i * 256); s += (v[i][0] + v[i][1]) + (v[i][2] + v[i][3]); }
        const float mu = wave_sum(s) * (1.f / 1024.f);
        float q = 0.f;
#pragma unroll
        for (int i = 0; i < 4; ++i) { const f32x4 d = v[i] - mu; q += (d[0] * d[0] + d[1] * d[1]) + (d[2] * d[2] + d[3] * d[3]); }
        const float rstd = 1.0f / sqrtf(wave_sum(q) * (1.f / 1024.f) + 1e-5f);
        const GAS float* cr = cond + (size_t)condrow(m) * 9216 + nextmod * 1024 + lane * 4;
#pragma unroll
        for (int i = 0; i < 4; ++i) {
            const f32x4 gv = *(const GAS f32x4*)(g + i * 256 + lane * 4), bv = *(const GAS f32x4*)(b + i * 256 + lane * 4);
            const f32x4 y = (v[i] - mu) * rstd * gv + bv;
            *(GAS f32x4*)(xr + i * 256) = y;
            if (nextmod >= 0) { const f32x4 sh = *(const GAS f32x4*)(cr + i * 256), sc = *(const GAS f32x4*)(cr + 1024 + i * 256); const f32x4 h = y * (1.f + sc) + sh;
                u32x2 wv; wv.x = cvt_pk_bf16(h[0], h[1]); wv.y = cvt_pk_bf16(h[2], h[3]); *(GAS u32x2*)(H + (size_t)m * 1024 + i * 256 + lane * 4) = wv; }
        }
    }
}
struct EpiAct {
    static constexpr bool PERM = false, AFTER_DRAIN = false; GAS bf16_t* O;
    __device__ __forceinline__ void operator()(const f32x4 (&acc)[2][2][4][2], const Unit& u, int wr, int wc, int fr, int fq) const {
        const int row0 = u.pm * 256 + wr * 64 + fr, ff0 = u.pn * 128 + wc * 16 + 4 * fq;
#pragma unroll
        for (int ai = 0; ai < 2; ++ai)
#pragma unroll
            for (int m = 0; m < 4; ++m) { GAS bf16_t* rowp = O + (size_t)(row0 + ai * 128 + m * 16) * 2816 + ff0;
#pragma unroll
                for (int bj = 0; bj < 2; ++bj) { const f32x4 g = acc[ai][bj][m][0], up = acc[ai][bj][m][1]; float a[4];
#pragma unroll
                    for (int j = 0; j < 4; ++j) a[j] = g[j] * __builtin_amdgcn_rcpf(1.f + __expf(-g[j])) * up[j];
                    u32x2 w; w.x = cvt_pk_bf16(a[0], a[1]); w.y = cvt_pk_bf16(a[2], a[3]); *(GAS u32x2*)(rowp + bj * 64) = w; } }
    }
};
struct EpiRes {
    static constexpr bool PERM = false, AFTER_DRAIN = false; const GAS float* xp; const GAS float* xs; GAS float* X; const GAS float* cond; int gidx; float gs; int row_off;
    __device__ __forceinline__ void operator()(const f32x4 (&acc)[2][2][4][2], const Unit& u, int wr, int wc, int fr, int fq) const {
        const int row0 = row_off + u.pm * 256 + wr * 64 + fr, col0 = u.pn * 256 + wc * 32 + 4 * fq;
        const GAS float* gr = cond + (size_t)condrow(row_off + u.pm * 256) * 9216 + gidx * 1024 + col0;
        f32x4 gv[2][2];
#pragma unroll
        for (int bj = 0; bj < 2; ++bj)
#pragma unroll
            for (int n = 0; n < 2; ++n) gv[bj][n] = gs * *(const GAS f32x4*)(gr + bj * 128 + n * 16);
#pragma unroll
        for (int ai = 0; ai < 2; ++ai)
#pragma unroll
            for (int m = 0; m < 4; ++m) { const int row = row0 + ai * 128 + m * 16;
                const GAS float* xr = (row < MCTX ? xp + (size_t)row * 1024 : xs + (size_t)(row - MCTX) * 1024) + col0;
                GAS float* o = X + (size_t)row * 1024 + col0;
#pragma unroll
                for (int bj = 0; bj < 2; ++bj)
#pragma unroll
                    for (int n = 0; n < 2; ++n) { const int off = bj * 128 + n * 16; const f32x4 xv = *(const GAS f32x4*)(xr + off);
                        *(GAS f32x4*)(o + off) = ALPHA * xv + gv[bj][n] * acc[ai][bj][m][n]; } }
    }
};
struct EpiIn {
    static constexpr bool PERM = false, AFTER_DRAIN = false; GAS bf16_t* Q; GAS bf16_t* Kb; GAS bf16_t* Pb; GAS float* newk;
    __device__ __forceinline__ void operator()(const f32x4 (&acc)[2][2][4][2], const Unit& u, int wr, int wc, int fr, int fq) const {
        const int row0 = u.pm * 256 + wr * 64 + fr;
        if (u.pn >= 4) {
            const int colbase = (u.pn - 4) * 256 + wc * 32 + 4 * fq;
#pragma unroll
            for (int ai = 0; ai < 2; ++ai)
#pragma unroll
                for (int m = 0; m < 4; ++m) { GAS bf16_t* rowp = Pb + (size_t)(row0 + ai * 128 + m * 16) * 2336;
#pragma unroll
                    for (int bj = 0; bj < 2; ++bj)
#pragma unroll
                        for (int n = 0; n < 2; ++n) { const int col = colbase + bj * 128 + n * 16; const f32x4 a = acc[ai][bj][m][n];
                            if (col < 2336) { u32x2 w; w.x = cvt_pk_bf16(a[0], a[1]); w.y = cvt_pk_bf16(a[2], a[3]); *(GAS u32x2*)(rowp + col) = w; } } }
        } else {
            const bool isK = u.pn >= 2, lat = u.pm >= 16;
            const int chbase = (u.pn & 1) * 256 + wc * 32 + 4 * fq;
            float invf[4];
#pragma unroll
            for (int j = 0; j < 4; ++j) invf[j] = __builtin_amdgcn_exp2f(-(float)(4 * fq + j) * 0.83048202372f) * 0.15915494309f;
#pragma unroll
            for (int ai = 0; ai < 2; ++ai)
#pragma unroll
                for (int m = 0; m < 4; ++m) { const int row = row0 + ai * 128 + m * 16;
                    float cs[4], sn[4]; int t = 0, b = 0;
                    if (lat) { t = (row - MCTX) & 2047; b = (row - MCTX) >> 11; const float pos = (float)((wc & 1) ? (t & 63) : (t >> 6));
#pragma unroll
                        for (int j = 0; j < 4; ++j) { const float rev = pos * invf[j]; cs[j] = __builtin_amdgcn_cosf(rev); sn[j] = __builtin_amdgcn_sinf(rev); } }
                    else {
#pragma unroll
                        for (int j = 0; j < 4; ++j) { cs[j] = 1.f; sn[j] = 0.f; } }
#pragma unroll
                    for (int bj = 0; bj < 2; ++bj) { const f32x4 x1 = acc[ai][bj][m][0], x2 = acc[ai][bj][m][1]; float o1[4], o2[4];
#pragma unroll
                        for (int j = 0; j < 4; ++j) { o1[j] = x1[j] * cs[j] - x2[j] * sn[j]; o2[j] = x1[j] * sn[j] + x2[j] * cs[j]; }
                        const int ch = chbase + bj * 128;
                        if (!isK) { GAS bf16_t* q = Q + (size_t)row * 512 + ch; u32x2 w;
                            w.x = cvt_pk_bf16(o1[0] * QSCALE, o1[1] * QSCALE); w.y = cvt_pk_bf16(o1[2] * QSCALE, o1[3] * QSCALE); *(GAS u32x2*)q = w;
                            w.x = cvt_pk_bf16(o2[0] * QSCALE, o2[1] * QSCALE); w.y = cvt_pk_bf16(o2[2] * QSCALE, o2[3] * QSCALE); *(GAS u32x2*)(q + 16) = w; }
                        else { const size_t krow = lat ? (size_t)(MCTX + b * 2560 + t) : (size_t)row; GAS bf16_t* kp = Kb + krow * 512 + ch; u32x2 w;
                            w.x = cvt_pk_bf16(o1[0], o1[1]); w.y = cvt_pk_bf16(o1[2], o1[3]); *(GAS u32x2*)kp = w;
                            w.x = cvt_pk_bf16(o2[0], o2[1]); w.y = cvt_pk_bf16(o2[2], o2[3]); *(GAS u32x2*)(kp + 16) = w;
                            if (!lat) { GAS float* nk = newk + ((size_t)(row >> 8) * 512 + (row & 255)) * 512 + ch; *(GAS f32x4*)nk = x1; *(GAS f32x4*)(nk + 16) = x2; } } } }
        }
    }
};
struct EpiLora {
    static constexpr bool PERM = false, AFTER_DRAIN = false; GAS bf16_t* O; const GAS float* w0; const GAS float* a0;
    __device__ __forceinline__ void operator()(const f32x4 (&acc)[2][2][4][2], const Unit& u, int wr, int wc, int fr, int fq) const {
        const int row0 = u.pm * 256 + wr * 64 + fr, c0 = wc * 32 + 4 * fq;
#pragma unroll
        for (int bj = 0; bj < 2; ++bj)
#pragma unroll
            for (int n = 0; n < 2; ++n) { const int col = c0 + bj * 128 + n * 16; f32x4 bias = (f32x4){0.f, 0.f, 0.f, 0.f};
                if (u.pn == 0) bias = *(const GAS f32x4*)(w0 + col); else if (u.pn == 1) bias = *(const GAS f32x4*)(a0 + col);
#pragma unroll
                for (int ai = 0; ai < 2; ++ai)
#pragma unroll
                    for (int m = 0; m < 4; ++m) { f32x4 v = acc[ai][bj][m][n] + bias;
                        if (u.pn < 2) { const float sc = u.pn == 0 ? 0.60653065971f : 1.f;
#pragma unroll
                            for (int j = 0; j < 4; ++j) v[j] = sc * __builtin_amdgcn_rcpf(1.f + __expf(-v[j])); }
                        u32x2 w; w.x = cvt_pk_bf16(v[0], v[1]); w.y = cvt_pk_bf16(v[2], v[3]);
                        *(GAS u32x2*)(O + (size_t)(row0 + ai * 128 + m * 16) * 768 + u.pn * 256 + col) = w; } }
    }
};
struct EpiVt {
    static constexpr bool PERM = false, AFTER_DRAIN = false; GAS bf16_t* Vt; GAS float* newv;
    __device__ __forceinline__ void operator()(const f32x4 (&acc)[2][2][4][2], const Unit& u, int wr, int wc, int fr, int fq) const {
        const int ch0 = u.pm * 256 + wr * 64 + fr, tok0 = u.pn * 256 + wc * 32 + 4 * fq;
#pragma unroll
        for (int ai = 0; ai < 2; ++ai)
#pragma unroll
            for (int m = 0; m < 4; ++m) { const int ch = ch0 + ai * 128 + m * 16;
#pragma unroll
                for (int bj = 0; bj < 2; ++bj)
#pragma unroll
                    for (int n = 0; n < 2; ++n) { const int tok = tok0 + bj * 128 + n * 16; const f32x4 a = acc[ai][bj][m][n]; size_t addr;
                        if (u.pn < 16) { const int b = u.pn, t = tok - 256 * b; addr = ((size_t)(b * 512 + ch)) * 256 + t; GAS float* nv = newv + ((size_t)b * 512 + t) * 512 + ch;
                            nv[0] = a[0]; nv[512] = a[1]; nv[1024] = a[2]; nv[1536] = a[3]; }
                        else { const int tl = tok - MCTX, b = tl >> 11, t = tl & 2047; addr = VT_LAT_OFF + ((size_t)(b * 512 + ch)) * 2560 + t; }
                        u32x2 w; w.x = cvt_pk_bf16(a[0], a[1]); w.y = cvt_pk_bf16(a[2], a[3]); *(GAS u32x2*)(Vt + addr) = w; } }
    }
};
__device__ __forceinline__ void prep_phase(PR P, int l, LAS float* lin  ) {
    const int tid = ltid();
    const GAS bf16_t* Pb = (const GAS bf16_t*)(gws(P) + WS_P);
    GAS bf16_t* EAG = (GAS bf16_t*)(gws(P) + WS_EAG); GAS float* GLA = (GAS float*)(gws(P) + WS_GLA);
    for (int u = lbid(); u < 1280 + 256; u += gridDim.x) {
        if (u < 1280) {
            const int m0 = u * 16; const bool lat = m0 >= MCTX; const int T = lat ? 2048 : 256; const int t0 = lat ? ((m0 - MCTX) & 2047) : (m0 & 255);
            {
                const int d = tid >> 8, cc = tid & 255, col = 768 + tid;
                const float mu0 = gin(P, I_MU)[(l * 2 + 0) * 1280 + col], mu1 = gin(P, I_MU)[(l * 2 + 1) * 1280 + col];
                const GAS bf16_t* pc = Pb + (size_t)m0 * 2336 + col;
                GAS bf16_t* lo = (GAS bf16_t*)(gws(P) + WS_H) + ((size_t)d * MTOK + m0) * 256 + cc;
                bf16_t raw[18];
                raw[0] = (t0 > 0) ? pc[-2336] : (bf16_t)0;
#pragma unroll
                for (int i = 0; i < 16; ++i) raw[i + 1] = pc[(size_t)i * 2336];
                raw[17] = (t0 + 16 < T) ? pc[(size_t)16 * 2336] : (bf16_t)0;
#pragma unroll
                for (int i = 0; i < 16; ++i) {
                    const float prev = bf2f(raw[i]), cur = bf2f(raw[i + 1]), nxt = bf2f(raw[i + 2]);
                    float v = cur + mu0 * (prev - cur) + mu1 * (nxt - cur);
                    if (cc < 64) v = tanhf(v); else if (cc >= 128) v = 1.f / (1.f + __expf(-v));
                    lo[(size_t)i * 256] = f2bf(v);
                }
            }
            {
                const int n = tid & 127, d = (tid >> 7) & 1, i0 = (tid >> 8) * 8;
                const GAS float* gau = gin(P, I_GAUP) + (size_t)(l * 2 + d) * 16 * 128 + n; const float bb = gin(P, I_GAB)[(l * 2 + d) * 128 + n];
                float up[16];
#pragma unroll
                for (int j = 0; j < 16; ++j) up[j] = gau[j * 128];
#pragma unroll 4
                for (int i = 0; i < 8; ++i) { const GAS bf16_t* ad = Pb + (size_t)(m0 + i0 + i) * 2336 + 1280 + 512 + 272 * d; float x = bb;
                    const u32x4 a0 = *(const GAS u32x4*)ad, a1 = *(const GAS u32x4*)(ad + 8);
#pragma unroll
                    for (int j = 0; j < 4; ++j) { x += __uint_as_float(a0[j] << 16) * up[2 * j] + __uint_as_float(a0[j] & 0xffff0000u) * up[2 * j + 1];
                                                  x += __uint_as_float(a1[j] << 16) * up[8 + 2 * j] + __uint_as_float(a1[j] & 0xffff0000u) * up[8 + 2 * j + 1]; }
                    const float ls = (x >= 0.f) ? -log1pf(expf(-x)) : x - log1pf(expf(x));
                    GLA[((size_t)d * MTOK + m0 + i0 + i) * 128 + n] = ls * (1.f / 16.f); }
            }
        } else {
            const int v = u - 1280, b = v >> 5, j0 = (v & 31) * 16, ch = tid;
            const GAS float* ck = gin(P, I_CK) + ((size_t)(b * 2 + l) * 512 + j0) * 512 + ch; const GAS float* cv = gin(P, I_CV) + ((size_t)(b * 2 + l) * 512 + j0) * 512 + ch;
            GAS bf16_t* Kb = (GAS bf16_t*)(gws(P) + WS_K) + ((size_t)(MCTX + b * 2560 + 2048 + j0)) * 512 + ch;
            float vv[16];
#pragma unroll
            for (int i = 0; i < 16; ++i) { Kb[(size_t)i * 512] = f2bf(ck[(size_t)i * 512]); vv[i] = cv[(size_t)i * 512]; }
            u32x4 w0, w1; w0.x = cvt_pk_bf16(vv[0], vv[1]); w0.y = cvt_pk_bf16(vv[2], vv[3]); w0.z = cvt_pk_bf16(vv[4], vv[5]); w0.w = cvt_pk_bf16(vv[6], vv[7]);
            w1.x = cvt_pk_bf16(vv[8], vv[9]); w1.y = cvt_pk_bf16(vv[10], vv[11]); w1.z = cvt_pk_bf16(vv[12], vv[13]); w1.w = cvt_pk_bf16(vv[14], vv[15]);
            GAS bf16_t* vt = (GAS bf16_t*)(gws(P) + WS_VT) + VT_LAT_OFF + ((size_t)(b * 512 + ch)) * 2560 + 2048 + j0;
            *(GAS u32x4*)vt = w0; *(GAS u32x4*)(vt + 8) = w1;
        }
    }
}

#define FMAC_BC(acc, vec, s, I) asm volatile("v_fmac_f32_dpp %0, %1, %2 row_newbcast:" #I " row_mask:0xf bank_mask:0xf" : "+v"(acc) : "v"(vec), "v"(s))
#define MUL_BC(dst, vec, s, I) asm volatile("v_mul_f32_dpp %0, %1, %2 row_newbcast:" #I " row_mask:0xf bank_mask:0xf" : "=v"(dst) : "v"(vec), "v"(s))
#define REP16(X) X(0) X(1) X(2) X(3) X(4) X(5) X(6) X(7) X(8) X(9) X(10) X(11) X(12) X(13) X(14) X(15)

#define LBAR() do { asm volatile("s_waitcnt lgkmcnt(0)" ::: "memory"); __builtin_amdgcn_s_barrier(); asm volatile("" ::: "memory"); } while (0)
__device__ __forceinline__ void rwkv_block(PR P, int l, int role  , LAS float* lf) {
    const int tid = ltid(), lane = tid & 63, w = __builtin_amdgcn_readfirstlane(tid >> 6), rg = w & 3; const bool helper = w >= 4;
    const bool lat = role < 64; const int s = lat ? role : role - 64;
    const int b = s >> 3, h = (s >> 1) & 3, d = s & 1, T = lat ? 2048 : 256;
    const int mbase = lat ? MCTX + b * 2048 : b * 256;
    LAS float* vec = lf;
    LAS float* post = lf + 12288;
    LAS float* ypart = lf + 16384;
    const GAS bf16_t* Pb = (const GAS bf16_t*)(gws(P) + WS_P); const GAS bf16_t* EAG = (const GAS bf16_t*)(gws(P) + WS_EAG) + (size_t)d * MTOK * 768;
    GAS bf16_t* MX = (GAS bf16_t*)(gws(P) + WS_H);
    const int ch = h * 64 + lane;
    const int nch = T / 16;
    if (!helper) {
        const int r16 = lane & 15, cb = lane >> 4, row = rg * 16 + r16;
        float S[16];
        if (lat) { const GAS float* s0 = gin(P, I_SRW) + ((((size_t)(b * 2 + l) * 2 + d) * 4 + h) * 64 + row) * 64 + cb * 16;
#pragma unroll
            for (int i = 0; i < 16; ++i) S[i] = s0[i]; }
        else {
#pragma unroll
            for (int i = 0; i < 16; ++i) S[i] = 0.f; }
        __builtin_amdgcn_s_waitcnt(0);
        LBAR();
#define RW_LDV(ST, KK_, R_, VROW_, W_, KA_, KD_) do { const LAS float* vp_ = vbuf + ((ST) * 6) * 64; KK_ = vp_[64 + lane]; R_ = vp_[256 + lane]; VROW_ = vp_[320 + row]; \
            _Pragma("unroll") for (int q = 0; q < 4; ++q) { W_[q] = *(const LAS f32x4*)(vp_ + cb * 16 + 4 * q); KA_[q] = *(const LAS f32x4*)(vp_ + 128 + cb * 16 + 4 * q); KD_[q] = *(const LAS f32x4*)(vp_ + 192 + cb * 16 + 4 * q); } } while (0)
#define RW_STEP(ST, KK_, R_, VROW_, W_, KA_, KD_) do { \
            float sa0 = 0.f, sa1 = 0.f, sa2 = 0.f, sa3 = 0.f; \
            REP16(SA_STEP2) \
            const float nsa = -xrow_sum4((sa0 + sa1) + (sa2 + sa3)); \
            _Pragma("unroll") for (int i = 0; i < 16; ++i) S[i] = fmaf(KD_[i >> 2][i & 3], VROW_, fmaf(KA_[i >> 2][i & 3], nsa, S[i] * W_[i >> 2][i & 3])); \
            float y0 = 0.f, y1 = 0.f, y2 = 0.f, y3 = 0.f; \
            REP16(Y_STEP2) \
            ybuf[(ST) * 256 + row * 4 + cb] = (y0 + y1) + (y2 + y3); } while (0)
#pragma unroll 1
        for (int c = 0; c < nch; ++c) {
            const LAS float* vbuf = vec + (c & 1) * 6144; LAS float* ybuf = ypart + (c & 1) * 4096;
            f32x4 Wa[4], KAa[4], KDa[4], Wb[4], KAb[4], KDb[4]; float kka_, ra_, vrowa_, kkb_, rb_, vrowb_;
            RW_LDV(0, kka_, ra_, vrowa_, Wa, KAa, KDa);
#pragma unroll 1
            for (int step = 0; step < 16; step += 2) {
                RW_LDV(step + 1, kkb_, rb_, vrowb_, Wb, KAb, KDb);
#define SA_STEP2(I) if (((I) & 3) == 0) FMAC_BC(sa0, kka_, S[I], I); else if (((I) & 3) == 1) FMAC_BC(sa1, kka_, S[I], I); else if (((I) & 3) == 2) FMAC_BC(sa2, kka_, S[I], I); else FMAC_BC(sa3, kka_, S[I], I);
#define Y_STEP2(I) if (((I) & 3) == 0) FMAC_BC(y0, ra_, S[I], I); else if (((I) & 3) == 1) FMAC_BC(y1, ra_, S[I], I); else if (((I) & 3) == 2) FMAC_BC(y2, ra_, S[I], I); else FMAC_BC(y3, ra_, S[I], I);
                RW_STEP(step, kka_, ra_, vrowa_, Wa, KAa, KDa);
#undef SA_STEP2
#undef Y_STEP2
                if (step + 2 < 16) RW_LDV(step + 2, kka_, ra_, vrowa_, Wa, KAa, KDa);
#define SA_STEP2(I) if (((I) & 3) == 0) FMAC_BC(sa0, kkb_, S[I], I); else if (((I) & 3) == 1) FMAC_BC(sa1, kkb_, S[I], I); else if (((I) & 3) == 2) FMAC_BC(sa2, kkb_, S[I], I); else FMAC_BC(sa3, kkb_, S[I], I);
#define Y_STEP2(I) if (((I) & 3) == 0) FMAC_BC(y0, rb_, S[I], I); else if (((I) & 3) == 1) FMAC_BC(y1, rb_, S[I], I); else if (((I) & 3) == 2) FMAC_BC(y2, rb_, S[I], I); else FMAC_BC(y3, rb_, S[I], I);
                RW_STEP(step + 1, kkb_, rb_, vrowb_, Wb, KAb, KDb);
#undef SA_STEP2
#undef Y_STEP2
            }
            LBAR();
        }
        if (!lat) { GAS float* so = gout(P) + O_NRW + ((((size_t)(b * 2 + l) * 2 + d) * 4 + h) * 64 + row) * 64 + cb * 16;
#pragma unroll
            for (int i = 0; i < 16; ++i) so[i] = S[i]; }
    } else {
        const float mu0r = gin(P, I_MU)[(l * 2) * 1280 + ch], mu1r = gin(P, I_MU)[(l * 2 + 1) * 1280 + ch];
        const float mu0k = gin(P, I_MU)[(l * 2) * 1280 + 256 + ch], mu1k = gin(P, I_MU)[(l * 2 + 1) * 1280 + 256 + ch];
        const float mu0v = gin(P, I_MU)[(l * 2) * 1280 + 512 + ch], mu1v = gin(P, I_MU)[(l * 2 + 1) * 1280 + 512 + ch];
        const float kkc = gin(P, I_KK)[l * 256 + ch], kac = gin(P, I_KA)[l * 256 + ch], rkc = gin(P, I_RK)[(l * 2 + d) * 256 + ch];
        const float gng = gin(P, I_GNG)[(l * 2 + d) * 256 + ch], gnb = gin(P, I_GNB)[(l * 2 + d) * 256 + ch];
        bf16_t Rr[6], Rk[6], Rv[6], Re[4], Ra[4], Rg[4];
#define RW_LOAD(CC) do { const int q0_ = (CC) * 16 + rg * 4, lo_ = d ? T - 4 - q0_ : q0_; \
            _Pragma("unroll") for (int j = 0; j < 6; ++j) { const int tt = lo_ - 1 + j; const bool ok = tt >= 0 && tt < T; const GAS bf16_t* pr = Pb + (size_t)(mbase + tt) * 2336 + ch; \
                Rr[j] = ok ? pr[0] : (bf16_t)0; Rk[j] = ok ? pr[256] : (bf16_t)0; Rv[j] = ok ? pr[512] : (bf16_t)0; } \
            _Pragma("unroll") for (int x = 0; x < 4; ++x) { const GAS bf16_t* eg = EAG + (size_t)(mbase + lo_ + x) * 768 + ch; Re[x] = eg[0]; Ra[x] = eg[256]; Rg[x] = eg[512]; } } while (0)
#define RW_PROCESS(BUF) do { _Pragma("unroll") for (int x = 0; x < 4; ++x) { \
                const int step = rg * 4 + (d ? 3 - x : x); \
                const float r0 = bf2f(Rr[x + 1]), k0 = bf2f(Rk[x + 1]), v0 = bf2f(Rv[x + 1]); \
                const float r = r0 + mu0r * (bf2f(Rr[x]) - r0) + mu1r * (bf2f(Rr[x + 2]) - r0), k = k0 + mu0k * (bf2f(Rk[x]) - k0) + mu1k * (bf2f(Rk[x + 2]) - k0), v = v0 + mu0v * (bf2f(Rv[x]) - v0) + mu1v * (bf2f(Rv[x + 2]) - v0); \
                const float e = bf2f(Re[x]), a = bf2f(Ra[x]), g = bf2f(Rg[x]); \
                const float kkv = k * kkc; const float kk = kkv * __builtin_amdgcn_rsqf(fmaxf(wave_sum(kkv * kkv), 1e-24f)); \
                const float kd = k * (1.f + (a - 1.f) * kac); \
                const float bonus = wave_sum(r * kd * rkc); \
                LAS float* vp_ = vec + (BUF) * 6144 + (step * 6) * 64 + lane; \
                vp_[0] = __expf(-e); vp_[64] = kk; vp_[128] = kk * a; vp_[192] = kd; vp_[256] = r; vp_[320] = v; \
                LAS float* pp = post + (BUF) * 2048 + (step * 2) * 64 + lane; pp[0] = g; pp[64] = bonus * v; } } while (0)
#define RW_POST(CC) do { const int q0_ = (CC) * 16 + rg * 4; \
            _Pragma("unroll") for (int i = 0; i < 4; ++i) { \
                const int step = rg * 4 + i; const int q = q0_ + i, tt = d ? T - 1 - q : q; const int m = mbase + tt; \
                const f32x4 yp = *(const LAS f32x4*)(ypart + ((CC) & 1) * 4096 + step * 256 + lane * 4); \
                const float y = (yp[0] + yp[1]) + (yp[2] + yp[3]); \
                const float mu = wave_sum(y) * (1.f / 64.f); const float dv = y - mu; const float var = wave_sum(dv * dv) * (1.f / 64.f); \
                const LAS float* pp = post + ((CC) & 1) * 2048 + (step * 2) * 64 + lane; \
                const float o = (dv * __builtin_amdgcn_rsqf(var + 64e-5f) * gng + gnb + pp[64]) * pp[0]; \
                MX[(size_t)m * 1536 + d * 256 + ch] = f2bf(o); } } while (0)
        __builtin_amdgcn_s_setprio(3);
        RW_LOAD(0);
        RW_PROCESS(0);
        if (nch > 1) RW_LOAD(1);
        LBAR();
#pragma unroll 1
        for (int c = 0; c < nch; ++c) {
            if (c >= 1) RW_POST(c - 1);
            if (c + 1 < nch) { RW_PROCESS((c + 1) & 1); if (c + 2 < nch) RW_LOAD(c + 2); }
            LBAR();
        }
        RW_POST(nch - 1);
        __builtin_amdgcn_s_setprio(0);
    }
    __syncthreads();
}
#define REP8(X) X(0) X(1) X(2) X(3) X(4) X(5) X(6) X(7)
__device__ __forceinline__ void gla_block(PR P, int l, int role  , LAS float* lf) {
    const int tid = ltid(), lane = tid & 63, w = __builtin_amdgcn_readfirstlane(tid >> 6), kg = w & 3; const bool helper = w >= 4;
    const bool lat = role < 64; const int s = lat ? role : role - 64;
    const int b = s >> 3, h = (s >> 1) & 3, d = s & 1, T = lat ? 2048 : 256;
    const int mbase = lat ? MCTX + b * 2048 : b * 256;
    LAS float* qb = lf;
    LAS float* kb = lf + 1024;
    LAS float* ab = lf + 2048;
    LAS float* vb = lf + 3072;
    LAS float* gb = lf + 5120;
    LAS float* opart = lf + 7168;
    const int nch = T / 16;
    if (!helper) {
        float S[8];
        if (lat) { const GAS float* s0 = gin(P, I_SGLA) + ((((size_t)(b * 2 + l) * 2 + d) * 4 + h) * 32 + kg * 8) * 64 + lane;
#pragma unroll
            for (int k = 0; k < 8; ++k) S[k] = s0[k * 64]; }
        else {
#pragma unroll
            for (int k = 0; k < 8; ++k) S[k] = 0.f; }
        __builtin_amdgcn_s_waitcnt(0);
        const int l7 = kg * 8 + (lane & 7);
        LBAR();
#pragma unroll 1
        for (int c = 0; c < nch; ++c) {
            const int bo = (c & 1);
#pragma unroll 1
            for (int step = 0; step < 16; ++step) {
                const int o_ = (bo * 16 + step) * 32 + l7;
                const float qv = qb[o_], kv = kb[o_], av = ab[o_], v = vb[(bo * 16 + step) * 64 + lane];
                float o0 = 0.f, o1 = 0.f, o2 = 0.f, o3 = 0.f;
#define GLA_A(I) MUL_BC(S[I], av, S[I], I);
#define GLA_B(I) FMAC_BC(S[I], kv, v, I);
#define GLA_C(I) if (((I) & 3) == 0) FMAC_BC(o0, qv, S[I], I); else if (((I) & 3) == 1) FMAC_BC(o1, qv, S[I], I); else if (((I) & 3) == 2) FMAC_BC(o2, qv, S[I], I); else FMAC_BC(o3, qv, S[I], I);
                REP8(GLA_A)
                REP8(GLA_B)
                REP8(GLA_C)
                opart[(bo * 16 + step) * 256 + kg * 64 + lane] = (o0 + o1) + (o2 + o3);
            }
            LBAR();
        }
        if (!lat) { GAS float* so = gout(P) + O_NGLA + ((((size_t)(b * 2 + l) * 2 + d) * 4 + h) * 32 + kg * 8) * 64 + lane;
#pragma unroll
            for (int k = 0; k < 8; ++k) so[k * 64] = S[k]; }
    } else {
        const GAS bf16_t* Pb = (const GAS bf16_t*)(gws(P) + WS_P) + 1280; const GAS float* GLA = (const GAS float*)(gws(P) + WS_GLA) + (size_t)d * MTOK * 128;
        GAS bf16_t* MX = (GAS bf16_t*)(gws(P) + WS_H);
        const float gn = gin(P, I_GGN)[l * 64 + lane];
        bf16_t Rqk[4], Rv[4], Rg[4]; float Ra[4];
#define GL_LOAD(CC) do { _Pragma("unroll") for (int i = 0; i < 4; ++i) { const int q = (CC) * 16 + kg * 4 + i, tt = d ? T - 1 - q : q; const size_t m = (size_t)(mbase + tt); \
                Rqk[i] = Pb[m * 2336 + (lane < 32 ? 0 : 128 - 32) + h * 32 + lane]; Ra[i] = GLA[m * 128 + h * 32 + (lane & 31)]; \
                Rv[i] = Pb[m * 2336 + 256 + h * 64 + lane]; Rg[i] = Pb[m * 2336 + 512 + 272 * d + 16 + h * 64 + lane]; } } while (0)
#define GL_PROCESS(BUF) do { _Pragma("unroll") for (int i = 0; i < 4; ++i) { const int step = kg * 4 + i; const float x = bf2f(Rqk[i]); \
                if (lane < 32) { qb[((BUF) * 16 + step) * 32 + lane] = x * 0.17677669529f; ab[((BUF) * 16 + step) * 32 + lane] = __expf(Ra[i]); } else kb[((BUF) * 16 + step) * 32 + lane - 32] = x; \
                vb[((BUF) * 16 + step) * 64 + lane] = bf2f(Rv[i]); gb[((BUF) * 16 + step) * 64 + lane] = bf2f(Rg[i]); } } while (0)
#define GL_POST(CC) do { _Pragma("unroll") for (int i = 0; i < 4; ++i) { const int step = kg * 4 + i; const int q = (CC) * 16 + step, tt = d ? T - 1 - q : q; const size_t m = (size_t)(mbase + tt); \
                const LAS float* op = opart + ((((CC) & 1)) * 16 + step) * 256 + lane; \
                const float o = (op[0] + op[64]) + (op[128] + op[192]); \
                const float ss = wave_sum(o * o) * (1.f / 64.f); const float gd = gb[(((CC) & 1) * 16 + step) * 64 + lane]; \
                const float r = o * __builtin_amdgcn_rsqf(ss + 1e-6f) * gn * (gd * __builtin_amdgcn_rcpf(1.f + __expf(-gd))); \
                MX[m * 1536 + 512 + d * 256 + h * 64 + lane] = f2bf(r); } } while (0)
        GL_LOAD(0);
        GL_PROCESS(0);
        if (nch > 1) GL_LOAD(1);
        LBAR();
#pragma unroll 1
        for (int c = 0; c < nch; ++c) {
            if (c >= 1) GL_POST(c - 1);
            if (c + 1 < nch) { GL_PROCESS((c + 1) & 1); if (c + 2 < nch) GL_LOAD(c + 2); }
            LBAR();
        }
        GL_POST(nch - 1);
    }
    __syncthreads();
}

typedef float f32x16 __attribute__((ext_vector_type(16)));
constexpr int QPITCH = 144;
constexpr int ATT_STAGE = 12288;
constexpr int ATT_WLDS = 32 * QPITCH + 8192;
__device__ __forceinline__ void attn_block_item(PR P, int l, int it, float lam, float lam_init, LAS unsigned char* lds) {
    const int tid = ltid(), lane = tid & 63, w = __builtin_amdgcn_readfirstlane(tid >> 6), q32 = lane & 31, hh = lane >> 5;
    LAS unsigned char* qlds = lds + 2 * ATT_STAGE + w * ATT_WLDS;
    LAS unsigned* park = (LAS unsigned*)(qlds + 32 * QPITCH);
    int b, h, Tk, m0; size_t krow0, vbase;
    if (it < 256) { b = it >> 5; h = (it >> 3) & 3; const int qb = it & 7; Tk = 2560; m0 = MCTX + b * 2048 + qb * 256 + w * 32; krow0 = (size_t)MCTX + (size_t)b * 2560; vbase = VT_LAT_OFF + ((size_t)(b * 512 + h * 128)) * 2560; }
    else { const int i2 = it - 256; b = i2 >> 2; h = i2 & 3; Tk = 256; m0 = b * 256 + w * 32; krow0 = (size_t)b * 256; vbase = ((size_t)(b * 512 + h * 128)) * 256; }
    const LAS unsigned char* qrd = qlds + q32 * QPITCH + hh * 16;
    const int kr = (tid & 255) >> 3, ksg = tid & 7, ve = tid >> 2, vks = tid & 3;
    const int kmrow = kr < 16 ? ((kr >> 2) * 8 + (kr & 3)) : (((kr - 16) >> 2) * 8 + 4 + (kr & 3));
    const unsigned kdst = (unsigned)((((ksg >> 1) * 64) + kmrow + 32 * (ksg & 1)) * 16);
    const unsigned vdst = (unsigned)(4096 + ((((ve >> 5) * 2 + (vks & 1)) * 64) + (ve & 31) + 32 * (vks >> 1)) * 16);
    const GAS bf16_t* Vg = (const GAS bf16_t*)(gws(P) + WS_VT) + vbase + (size_t)ve * Tk + vks * 8;
    const int ntile = Tk / 32;
#pragma unroll 1
    for (int c = 0; c < 2; ++c) {
        const GAS bf16_t* Kg = (const GAS bf16_t*)(gws(P) + WS_K) + (krow0 + kr) * 512 + h * 128 + c * 64 + ksg * 8;
        {
            const GAS bf16_t* Qg = (const GAS bf16_t*)(gws(P) + WS_Q) + (size_t)(m0 + q32) * 512 + h * 128 + c * 64 + hh * 32;
#pragma unroll
            for (int j = 0; j < 4; ++j) *(LAS u32x4*)(qlds + q32 * QPITCH + hh * 64 + j * 16) = *(const GAS u32x4*)(Qg + j * 8);
        }
        {
            u32x4 kreg = (u32x4){0u, 0u, 0u, 0u}; if (tid < 256) kreg = *(const GAS u32x4*)Kg;
            const u32x4 vreg = *(const GAS u32x4*)Vg;
            if (tid < 256) *(LAS u32x4*)(lds + kdst) = kreg;
            *(LAS u32x4*)(lds + vdst) = vreg;
        }
        LBAR();
        f32x16 O[4];
#pragma unroll
        for (int eb = 0; eb < 4; ++eb)
#pragma unroll
            for (int i = 0; i < 16; ++i) O[eb][i] = 0.f;
        float mrun = -1e30f, lrun = 0.f;
#pragma unroll 1
        for (int t = 0; t < ntile; ++t) {
            const bool more = t + 1 < ntile;
            u32x4 kreg = (u32x4){0u, 0u, 0u, 0u}, vreg = (u32x4){0u, 0u, 0u, 0u};
            if (more) { if (tid < 256) kreg = *(const GAS u32x4*)(Kg + (size_t)(t + 1) * 32 * 512); vreg = *(const GAS u32x4*)(Vg + (t + 1) * 32); }
            const LAS unsigned char* st = lds + (t & 1) * ATT_STAGE + lane * 16;
            f32x16 sc;
#pragma unroll
            for (int i = 0; i < 16; ++i) sc[i] = 0.f;
#pragma unroll
            for (int j = 0; j < 4; ++j) { const bf16x8 kf = *(const LAS bf16x8*)(st + j * 1024); const bf16x8 qf = *(const LAS bf16x8*)(qrd + j * 32); sc = __builtin_amdgcn_mfma_f32_32x32x16_bf16(kf, qf, sc, 0, 0, 0); }
            float mx = sc[0];
#pragma unroll
            for (int i = 1; i < 16; ++i) mx = fmaxf(mx, sc[i]);
            mx = xhalf_max(mx);
            const bool need = mx > mrun + 11.5f;
            if (__builtin_amdgcn_ballot_w64(need) != 0ull) {
                const float mnew = need ? mx : mrun; const float alpha = __builtin_amdgcn_exp2f(mrun - mnew); mrun = mnew; lrun *= alpha;
#pragma unroll
                for (int eb = 0; eb < 4; ++eb)
#pragma unroll
                    for (int i = 0; i < 16; ++i) O[eb][i] *= alpha;
            }
            float p[16]; float rs = 0.f;
#pragma unroll
            for (int i = 0; i < 16; ++i) { p[i] = __builtin_amdgcn_exp2f(sc[i] - mrun); rs += p[i]; }
            lrun += xhalf_sum(rs);
            bf16x8 pf[2];
#pragma unroll
            for (int mm = 0; mm < 2; ++mm) { u32x4 wv;
                asm volatile("v_cvt_pk_bf16_f32 %0, %4, %5\n\tv_cvt_pk_bf16_f32 %1, %6, %7\n\tv_cvt_pk_bf16_f32 %2, %8, %9\n\tv_cvt_pk_bf16_f32 %3, %10, %11\n\ts_nop 1"
                             : "=&v"(wv[0]), "=&v"(wv[1]), "=&v"(wv[2]), "=&v"(wv[3])
                             : "v"(p[8 * mm]), "v"(p[8 * mm + 1]), "v"(p[8 * mm + 2]), "v"(p[8 * mm + 3]), "v"(p[8 * mm + 4]), "v"(p[8 * mm + 5]), "v"(p[8 * mm + 6]), "v"(p[8 * mm + 7]));
                pf[mm] = __builtin_bit_cast(bf16x8, wv); }
#pragma unroll
            for (int eb = 0; eb < 4; ++eb)
#pragma unroll
                for (int mm = 0; mm < 2; ++mm) { const bf16x8 vf = *(const LAS bf16x8*)(st + 4096 + (eb * 2 + mm) * 1024); O[eb] = __builtin_amdgcn_mfma_f32_32x32x16_bf16(vf, pf[mm], O[eb], 0, 0, 0); }
            if (more) { LAS unsigned char* nx = lds + ((t + 1) & 1) * ATT_STAGE; if (tid < 256) *(LAS u32x4*)(nx + kdst) = kreg; *(LAS u32x4*)(nx + vdst) = vreg; }
            LBAR();
        }
        if (c == 0) {
            const float i1 = 1.f / lrun;
#pragma unroll
            for (int eb = 0; eb < 4; ++eb)
#pragma unroll
                for (int i2 = 0; i2 < 8; ++i2) park[(eb * 8 + i2) * 64 + lane] = cvt_pk_bf16(O[eb][2 * i2] * i1, O[eb][2 * i2 + 1] * i1);
        } else {
            const float i2s = lam / lrun; float ss = 0.f;
#pragma unroll
            for (int eb = 0; eb < 4; ++eb)
#pragma unroll
                for (int i2 = 0; i2 < 8; ++i2) { const unsigned wv = park[(eb * 8 + i2) * 64 + lane];
                    const float o0 = __uint_as_float(wv << 16) - O[eb][2 * i2] * i2s, o1 = __uint_as_float(wv & 0xffff0000u) - O[eb][2 * i2 + 1] * i2s;
                    O[eb][2 * i2] = o0; O[eb][2 * i2 + 1] = o1; ss += o0 * o0 + o1 * o1; }
            ss = xhalf_sum(ss);
            const float rn = (1.0f / sqrtf(ss * (1.f / 128.f) + 1e-6f)) * (1.f - lam_init);
            GAS bf16_t* op = (GAS bf16_t*)(gws(P) + WS_H) + (size_t)(m0 + q32) * 1536 + 1024 + h * 128;
            const GAS float* gn = gin(P, I_DGN) + l * 128;
#pragma unroll
            for (int eb = 0; eb < 4; ++eb)
#pragma unroll
                for (int i4 = 0; i4 < 4; ++i4) { const int e = eb * 32 + i4 * 8 + 4 * hh; const f32x4 g = *(const GAS f32x4*)(gn + e);
                    u32x2 wv; wv.x = cvt_pk_bf16(O[eb][i4 * 4] * rn * g[0], O[eb][i4 * 4 + 1] * rn * g[1]); wv.y = cvt_pk_bf16(O[eb][i4 * 4 + 2] * rn * g[2], O[eb][i4 * 4 + 3] * rn * g[3]);
                    *(GAS u32x2*)(op + e) = wv; }
        }
    }
}

__device__ __forceinline__ void mixer_phase(PR P, int l, LAS unsigned char* lds) {
    const int lane = ltid() & 63, w = ltid() >> 6;
    for (int role = lbid(); role < 384; role += gridDim.x) {
        if (role < 128) rwkv_block(P, l, 64 + role, (LAS float*)lds);
        else if (role < 192) rwkv_block(P, l, role - 128, (LAS float*)lds);
        else if (role < 256) gla_block(P, l, role - 192, (LAS float*)lds);
        else gla_block(P, l, 64 + (role - 256), (LAS float*)lds);
    }
    __syncthreads();
    const GAS float* lp = gin(P, I_LAM) + l * 256;
    const float s1 = wave_sum(lp[lane] * lp[64 + lane]), s2 = wave_sum(lp[128 + lane] * lp[192 + lane]);
    const float lam_init = (l == 0) ? 0.2f : 0.35550906759f;
    const float lam = expf(s1) - expf(s2) + lam_init;
    for (;;) {
        LAS unsigned* slot = (LAS unsigned*)(lds + 131072 + 400);
        if (ltid() == 0) *slot = __hip_atomic_fetch_add((GAS unsigned*)(gws(P) + WS_CTL) + l, 1u, __ATOMIC_RELAXED, __HIP_MEMORY_SCOPE_AGENT);
        __syncthreads();
        const unsigned it = (unsigned)__builtin_amdgcn_readfirstlane((int)*slot);
        __syncthreads();
        if (it >= 320u) break;
        attn_block_item(P, l, (int)it, lam, lam_init, lds);
    }
}
__device__ __forceinline__ int lsg(int v) { asm volatile("" : "+s"(v)); return v; }
__device__ __forceinline__ void run_gemm_ffn_up(PR P, LAS unsigned char* lds, int f) {
    Gemm g{(const unsigned short*)((const GAS bf16_t*)(gws(P) + (f == 1 ? WS_H3 : WS_H))), (const unsigned short*)((const GAS bf16_t*)(gws(P) + WS_WGU) + (size_t)f * 5632 * 1024), lsg(MTOK), lsg(5632), lsg(1024)};
    StaticOrder S; S.init(g.M, g.N, (int)gridDim.x, (int)blockIdx.x);
    EpiAct E{(GAS bf16_t*)(gws(P) + WS_ACT)};
    gemm_phase<EpiAct, StaticOrder, false>(lds, g, S, E, nullptr);
}
__device__ __forceinline__ void run_gemm_res(PR P, LAS unsigned char* lds, const GAS bf16_t* A, const GAS bf16_t* Bt, int K, const GAS float* xp, const GAS float* xs, int l, int gidx, float gs, int part) {
    const int G = (int)gridDim.x, bid = lbid();
    if (part == 0) {
        Gemm g{(const unsigned short*)(A + (size_t)MCTX * K), (const unsigned short*)Bt, lsg(MTOK - MCTX), lsg(1024), lsg(K)};
        StaticOrder S; S.init(g.M, g.N, G, bid);
        EpiRes E{xp, xs, gout(P), (const GAS float*)(gws(P) + WS_COND) + (size_t)l * 9 * 9216, gidx, gs, MCTX};
        gemm_phase<EpiRes, StaticOrder, false>(lds, g, S, E, nullptr);
    } else {
        Gemm g{(const unsigned short*)A, (const unsigned short*)Bt, lsg(MCTX), lsg(1024), lsg(K)};
        StaticOrder S; S.init(g.M, g.N, G < 64 ? G : 64, bid);
        EpiRes E{xp, xs, gout(P), (const GAS float*)(gws(P) + WS_COND) + (size_t)l * 9 * 9216, gidx, gs, 0};
        gemm_phase<EpiRes, StaticOrder, false>(lds, g, S, E, nullptr);
    }
}
#define RES_AND_LN(A_, Bt_, K_, xp_, xs_, gidx_, gs_, which_, nextmod_, lc_) do { \
        { PR P = PARAMS; run_gemm_res(P, lds, A_, Bt_, K_, xp_, xs_, l, gidx_, gs_, 0); } \
        gbar(lds); \
        { PR P = PARAMS; const int G_ = (int)gridDim.x, bid_ = lbid(); \
          if (G_ > 64) { if (bid_ < 64) run_gemm_res(P, lds, A_, Bt_, K_, xp_, xs_, l, gidx_, gs_, 1); else ln_phase(P, l, which_, nextmod_, lc_, MCTX, MTOK, G_ - 64, bid_ - 64); } \
          else run_gemm_res(P, lds, A_, Bt_, K_, xp_, xs_, l, gidx_, gs_, 1); } \
        gbar(lds); \
        { PR P = PARAMS; const int G_ = (int)gridDim.x; if (G_ <= 64) ln_phase(P, l, which_, nextmod_, lc_, MCTX, MTOK, G_, lbid()); ln_phase(P, l, which_, nextmod_, lc_, 0, MCTX, G_, lbid()); } \
    } while (0)
__device__ __forceinline__ void run_gemm_in(PR P, LAS unsigned char* lds, int l) {
    { Gemm g{(const unsigned short*)((const GAS bf16_t*)(gws(P) + WS_H)), (const unsigned short*)((const GAS bf16_t*)(gws(P) + WS_WIN)), lsg(MTOK), lsg(3584), lsg(1024)};
      StaticOrder S; S.init(g.M, g.N, (int)gridDim.x, (int)blockIdx.x);
      EpiIn E{(GAS bf16_t*)(gws(P) + WS_Q), (GAS bf16_t*)(gws(P) + WS_K), (GAS bf16_t*)(gws(P) + WS_P), gout(P) + O_NK + (size_t)l * 256 * 512};
      gemm_phase<EpiIn, StaticOrder, false>(lds, g, S, E, nullptr); }
    { Gemm g{(const unsigned short*)((const GAS bf16_t*)(gws(P) + WS_WIN) + (size_t)3584 * 1024), (const unsigned short*)((const GAS bf16_t*)(gws(P) + WS_H)), lsg(512), lsg(MTOK), lsg(1024)};
      const int G = (int)gridDim.x; StaticOrder S; S.init(g.M, g.N, G, (int)((blockIdx.x + G - (1120 % G)) % G));
      EpiVt E{(GAS bf16_t*)(gws(P) + WS_VT), gout(P) + O_NV + (size_t)l * 256 * 512};
      gemm_phase<EpiVt, StaticOrder, false>(lds, g, S, E, nullptr); }
}

__device__ __forceinline__ void run_gemm_lora(PR P, LAS unsigned char* lds, int l) {
#pragma unroll 1
    for (int d = 0; d < 2; ++d) {
        Gemm g{(const unsigned short*)((const GAS bf16_t*)(gws(P) + WS_H) + (size_t)d * MTOK * 256), (const unsigned short*)((const GAS bf16_t*)(gws(P) + WS_WLORA) + (size_t)d * 768 * 256), lsg(MTOK), lsg(768), lsg(256)};
        const int G = (int)gridDim.x; StaticOrder S; S.init(g.M, g.N, G, (int)((lbid() + G - ((d * 240) % G)) % G));
        EpiLora E{(GAS bf16_t*)(gws(P) + WS_EAG) + (size_t)d * MTOK * 768, gin(P, I_W0) + (l * 2 + d) * 256, gin(P, I_A0) + (l * 2 + d) * 256};
        gemm_phase<EpiLora, StaticOrder, false>(lds, g, S, E, nullptr);
    }
}
__device__ __forceinline__ const LAS Params* lpar(LAS unsigned char* lds) { const LAS Params* q = (const LAS Params*)(lds + 131072); asm volatile("" : "+s"(q)); return q; }
#define PARAMS (*lpar(lds))
__device__ __forceinline__ void gbar(LAS unsigned char* lds) {
    PR P = PARAMS; XcdBarrier b; b.bar = (unsigned*)(gws(P) + WS_XBAR); b.x = xb_xcc_id(); b.st = (volatile LAS unsigned*)(lds + 131072 + 384);
    xcd_barrier(b);
}
__global__ void __launch_bounds__(512, 2) mega(ParamsH Pk) {
    extern __shared__ __attribute__((aligned(16))) unsigned char smem[];
    LAS unsigned char* lds = (LAS unsigned char*)smem;
    cg::grid_group grid = cg::this_grid();
    if (threadIdx.x < 35) ((LAS unsigned long long*)(lds + 131072))[threadIdx.x] = ((const __attribute__((address_space(4))) unsigned long long*)__builtin_amdgcn_kernarg_segment_ptr())[threadIdx.x];
    if (threadIdx.x < 2) ((LAS unsigned*)(lds + 131072 + 384))[threadIdx.x] = 0u;
    __syncthreads();
    { PR P = PARAMS; (void)xcd_barrier_post((unsigned*)(gws(P) + WS_XBAR), (volatile LAS unsigned*)(lds + 131072 + 384)); }
    grid.sync();
    convert_weights(PARAMS, 0, (LAS float*)lds);
    cond_phase(PARAMS, (LAS float*)lds);
    gbar(lds);
    mod_phase0(PARAMS);
    gbar(lds);
#pragma unroll 1
    for (int l = 0; l < 2; ++l) {
        run_gemm_ffn_up(PARAMS, lds, 0);
        gbar(lds);
        { const GAS float* xp; const GAS float* xs; { PR P = PARAMS; if (l == 0) { xp = gin(P, I_XP); xs = gin(P, I_XS); } else { xp = gout(P); xs = gout(P) + (size_t)MCTX * 1024; } }
          RES_AND_LN((const GAS bf16_t*)(gws(P) + WS_ACT), (const GAS bf16_t*)(gws(P) + WS_WD), 2816, xp, xs, 2, 0.5f, 0, 3, l); }
        gbar(lds);
        run_gemm_in(PARAMS, lds, l);
        gbar(lds);
        prep_phase(PARAMS, l, (LAS float*)lds);
        gbar(lds);
        run_gemm_lora(PARAMS, lds, l);
        gbar(lds);
        mixer_phase(PARAMS, l, lds);
        gbar(lds);
        RES_AND_LN((const GAS bf16_t*)(gws(P) + WS_H), (const GAS bf16_t*)(gws(P) + WS_WOUT), 1536, gout(P), gout(P) + (size_t)MCTX * 1024, 5, 1.0f, 1, 6, l);
        gbar(lds);
        run_gemm_ffn_up(PARAMS, lds, 1);
        gbar(lds);
        RES_AND_LN((const GAS bf16_t*)(gws(P) + WS_ACT), (const GAS bf16_t*)(gws(P) + WS_WD) + (size_t)1024 * 2816, 2816, gout(P), gout(P) + (size_t)MCTX * 1024, 8, 0.5f, 2, (l == 0 ? 0 : -1), l + 1);
        if (l == 0) convert_weights(PARAMS, 1, (LAS float*)lds);
        gbar(lds);
    }
}
extern "C" void kernel_launch(void* const* d_in, const int* in_sizes, int n_in, void* d_out, int out_size, void* d_ws, size_t ws_size, hipStream_t stream) {
    constexpr size_t kDynLds = 131072 + 512;
    static int grid_blocks = 0;
    if (!grid_blocks) {
        int dev = 0, cus = 0, per_cu = 0;
        hipGetDevice(&dev);
        hipDeviceGetAttribute(&cus, hipDeviceAttributeMultiprocessorCount, dev);
        hipFuncSetAttribute((const void*)mega, hipFuncAttributeMaxDynamicSharedMemorySize, (int)kDynLds);
        hipOccupancyMaxActiveBlocksPerMultiprocessor(&per_cu, (const void*)mega, 512, kDynLds);
        if (per_cu < 1) { fprintf(stderr, "occupancy query says %d blocks/CU\n", per_cu); per_cu = 1; }
        if (per_cu > 1) per_cu = 1;
        grid_blocks = cus * per_cu;
        if (ws_size < WS_END) fprintf(stderr, "workspace too small: %zu < %zu\n", ws_size, (size_t)WS_END);
    }
    ParamsH p{};
    for (int i = 0; i < 33; ++i) p.in[i] = (const float*)d_in[i];
    p.out = (float*)d_out; p.ws = (unsigned char*)d_ws;
    hipMemsetAsync(d_ws, 0, 16384, stream);
    void* args[] = {&p};
    hipError_t e = hipLaunchCooperativeKernel((const void*)mega, dim3(grid_blocks), dim3(512), args, kDynLds, stream);
    if (e != hipSuccess) fprintf(stderr, "cooperative launch failed: %s (grid %d)\n", hipGetErrorString(e), grid_blocks);
}
```

```cpp
#include <hip/hip_runtime.h>
#include <hip/hip_cooperative_groups.h>
#include <cstdio>
namespace cg = cooperative_groups;
namespace pg8 {
#define PG8_LAS __attribute__((address_space(3)))
typedef unsigned short bf16_t;
typedef short bf16x8 __attribute__((ext_vector_type(8)));
typedef float f32x4 __attribute__((ext_vector_type(4)));
typedef unsigned u32x4 __attribute__((ext_vector_type(4)));
constexpr int BM = 256, BK = 64, HALF = 128, HTB = HALF * BK * 2  , STAGE_BYTES = 8 * HTB, NXCD = 8, WGM = 8;

__host__ __device__ __forceinline__ int lds_byte(int r, int c) { const int st = (r >> 4) * 2 + (c >> 5), rr = r & 15, cc = c & 31, ob = rr * 64 + cc * 2; return st * 1024 + (ob ^ (((ob >> 9) & 1) << 5)); }
__host__ __device__ __forceinline__ void stage_rc(int b, int& R, int& C) { const int st = b / 1024, sb = b % 1024, swz = sb ^ (((sb >> 9) & 1) << 5); R = (st >> 1) * 16 + swz / 64; C = (st & 1) * 32 + (swz % 64) / 2; }
__host__ __device__ __forceinline__ int perm32(int rho) { const int n = rho >> 4, i = rho & 15; return 8 * (i >> 2) + 4 * n + (i & 3); }

struct Unit { int pm, pn; };
struct Gemm { const bf16_t* A; const bf16_t* Bt; int M, N, K; };

struct StaticOrder {
    int nM, nN, nwg, G, c;
    __host__ __device__ void init(int M, int N, int G_, int c_) { nM = M / BM; nN = N / BM; nwg = nM * nN; G = G_; c = c_; }
    __host__ __device__ bool next(int i, Unit& u) const {
        const long L = (long)i * G + c; if (L >= nwg) return false;
        int wgid = (int)L; { const int q = nwg / NXCD, r = nwg % NXCD, xcd = wgid % NXCD, off = wgid / NXCD; wgid = (xcd < r ? xcd * (q + 1) : r * (q + 1) + (xcd - r) * q) + off; }
        const int nig = WGM * nN, gid = wgid / nig, fm = gid * WGM, gsz = (nM - fm) < WGM ? (nM - fm) : WGM;
        u.pm = fm + ((wgid % nig) % gsz); u.pn = (wgid % nig) / gsz; return true;
    }
    __device__ __forceinline__ void a_ready(const Unit&) const {}
    __device__ __forceinline__ void done(const Unit&) const {}
};
__device__ __forceinline__ unsigned cvt_pk_bf16(float lo, float hi) { unsigned r; asm volatile("v_cvt_pk_bf16_f32 %0, %1, %2" : "=v"(r) : "v"(lo), "v"(hi)); return r; }
typedef float f32x2 __attribute__((ext_vector_type(2)));
template <class Epi, class Sched, bool STAMP = false>
__device__ __forceinline__ void gemm_phase(PG8_LAS unsigned char* lds, const Gemm g, const Sched& S, const Epi& E, unsigned long long* stamps) {
    int tid_ = threadIdx.x; asm volatile("" : "+v"(tid_));
    const int tid = tid_, wid = __builtin_amdgcn_readfirstlane(tid >> 6), lane = tid & 63, wr = wid >> 2, wc = wid & 3, fr = lane & 15, fq = lane >> 4;
    const int K = g.K, nt = K / BK;
    int ts_lo = 0, ts_hi = 0, nts = 0; const unsigned long long rt_entry = STAMP ? (unsigned long long)wall_clock64() : 0ull;
#define PG8_STAMP() do { if (STAMP && wid == 0 && nts < 64) { const unsigned long long _c = (unsigned long long)clock64(); \
        ts_lo = (lane == nts) ? (int)(unsigned)_c : ts_lo; ts_hi = (lane == nts) ? (int)(unsigned)(_c >> 32) : ts_hi; ++nts; } } while (0)
    PG8_STAMP();
    unsigned voffA[2], voffB[2];
#pragma unroll
    for (int i = 0; i < 2; ++i) { int R, C; stage_rc(tid * 16 + i * 8192, R, C); const int Rb = Epi::PERM ? ((R & ~31) + perm32(R & 31)) : R;
        voffA[i] = (unsigned)(R * K + C) * 2u; voffB[i] = (unsigned)(Rb * K + C) * 2u; }
    const size_t kstep = (size_t)(BK * 2);
    const size_t hstep = (size_t)HALF * K * 2;
    const size_t tstep = 2 * hstep;
    const unsigned ldsw = (unsigned)wid * 1024u;
    const int aoff = lds_byte(wr * 64 + fr, fq * 8), boff = lds_byte(wc * 32 + fr, fq * 8);
#define PG8_SA(b, h) (((b) * 2 + (h)) * HTB)
#define PG8_SB(b, h) ((4 + (b) * 2 + (h)) * HTB)
#define PG8_STAGE(bufoff, gbase, voff) do { _Pragma("unroll") for (int _i = 0; _i < 2; ++_i) \
        __builtin_amdgcn_global_load_lds((const unsigned*)((const char*)(gbase) + (voff)[_i]), (PG8_LAS unsigned*)(lds + (bufoff) + ldsw + _i * 8192), 16, 0, 0); } while (0)
#define PG8_LDA(dst, b, h) do { _Pragma("unroll") for (int m = 0; m < 4; ++m) _Pragma("unroll") for (int k = 0; k < 2; ++k) dst[m][k] = *(const PG8_LAS bf16x8*)(lds + PG8_SA(b, h) + aoff + m * 2048 + k * 1024); } while (0)
#define PG8_LDB(dst, b, h) do { _Pragma("unroll") for (int n = 0; n < 2; ++n) _Pragma("unroll") for (int k = 0; k < 2; ++k) dst[n][k] = *(const PG8_LAS bf16x8*)(lds + PG8_SB(b, h) + boff + n * 2048 + k * 1024); } while (0)
#define PG8_MMA(ai, bj, At, Bt) do { __builtin_amdgcn_s_setprio(1); _Pragma("unroll") for (int m = 0; m < 4; ++m) _Pragma("unroll") for (int n = 0; n < 2; ++n) _Pragma("unroll") for (int k = 0; k < 2; ++k) \
        acc[ai][bj][m][n] = __builtin_amdgcn_mfma_f32_16x16x32_bf16(Bt[n][k], At[m][k], acc[ai][bj][m][n], 0, 0, 0); __builtin_amdgcn_s_setprio(0); } while (0)
#define PG8_WAIT_V(n) asm volatile("s_waitcnt vmcnt(" #n ")" ::: "memory")
#define PG8_WAIT_L(n) asm volatile("s_waitcnt lgkmcnt(" #n ")" ::: "memory")
#define PG8_BAR __builtin_amdgcn_s_barrier()
#define PG8_SCHED __builtin_amdgcn_sched_barrier(0)
    Unit cur, nxt; int ui = 0;
    if (!S.next(0, cur)) return;
    f32x4 acc[2][2][4][2];
#pragma unroll
    for (int a = 0; a < 2; ++a)
#pragma unroll
        for (int b = 0; b < 2; ++b)
#pragma unroll
            for (int m = 0; m < 4; ++m)
#pragma unroll
                for (int n = 0; n < 2; ++n) acc[a][b][m][n] = (f32x4){0.f, 0.f, 0.f, 0.f};
    bf16x8 At[4][2], B0[2][2], B1[2][2];
    const char* cA = (const char*)g.A + (size_t)cur.pm * tstep; const char* cB = (const char*)g.Bt + (size_t)cur.pn * tstep;
    S.a_ready(cur);
    PG8_STAGE(PG8_SB(0, 0), cB, voffB); PG8_STAGE(PG8_SA(0, 0), cA, voffA); PG8_STAGE(PG8_SB(0, 1), cB + hstep, voffB); PG8_STAGE(PG8_SA(0, 1), cA + hstep, voffA);
    if (wr == 1) PG8_BAR;
    PG8_WAIT_V(4); PG8_BAR;
    PG8_STAGE(PG8_SB(1, 0), cB + kstep, voffB); PG8_STAGE(PG8_SA(1, 0), cA + kstep, voffA); PG8_STAGE(PG8_SB(1, 1), cB + hstep + kstep, voffB);
    PG8_WAIT_V(6); PG8_BAR;
    PG8_STAMP();
    for (;;) {
        const bool has_next = S.next(ui + 1, nxt);
        const char* nA = has_next ? (const char*)g.A + (size_t)nxt.pm * tstep : cA; const char* nB = has_next ? (const char*)g.Bt + (size_t)nxt.pn * tstep : cB;
        for (int t = 0; t < nt; t += 2) {
            const bool last = (t == nt - 2);
            const char* a1 = cA + (size_t)(t + 1) * kstep;
            const char* a2 = last ? nA : cA + (size_t)(t + 2) * kstep; const char* b2 = last ? nB : cB + (size_t)(t + 2) * kstep;
            const char* a3 = a2 + kstep; const char* b3 = b2 + kstep;
            if (last && has_next) S.a_ready(nxt);
            PG8_LDB(B0, 0, 0); PG8_SCHED; PG8_LDA(At, 0, 0); PG8_STAGE(PG8_SA(1, 1), a1 + hstep, voffA);
            PG8_WAIT_L(8); PG8_BAR; PG8_WAIT_L(0); PG8_MMA(0, 0, At, B0); PG8_BAR; PG8_SCHED;
            PG8_LDB(B1, 0, 1); PG8_STAGE(PG8_SB(0, 0), b2, voffB);
            PG8_BAR; PG8_WAIT_L(0); PG8_MMA(0, 1, At, B1); PG8_BAR;
            PG8_LDA(At, 0, 1); PG8_STAGE(PG8_SA(0, 0), a2, voffA);
            PG8_BAR; PG8_WAIT_L(0); PG8_MMA(1, 0, At, B0); PG8_BAR; PG8_SCHED;
            PG8_STAGE(PG8_SB(0, 1), b2 + hstep, voffB);
            PG8_WAIT_V(6); PG8_BAR; PG8_MMA(1, 1, At, B1); PG8_BAR;
            PG8_LDB(B0, 1, 0); PG8_SCHED; PG8_LDA(At, 1, 0); PG8_STAGE(PG8_SA(0, 1), a2 + hstep, voffA);
            PG8_WAIT_L(8); PG8_BAR; PG8_WAIT_L(0); PG8_MMA(0, 0, At, B0); PG8_BAR; PG8_SCHED;
            PG8_LDB(B1, 1, 1); PG8_STAGE(PG8_SB(1, 0), b3, voffB);
            PG8_BAR; PG8_WAIT_L(0); PG8_MMA(0, 1, At, B1); PG8_BAR;
            PG8_LDA(At, 1, 1); PG8_STAGE(PG8_SA(1, 0), a3, voffA);
            PG8_BAR; PG8_WAIT_L(0); PG8_MMA(1, 0, At, B0); PG8_BAR; PG8_SCHED;
            PG8_STAGE(PG8_SB(1, 1), b3 + hstep, voffB);
            PG8_WAIT_V(6); PG8_BAR; PG8_MMA(1, 1, At, B1); PG8_BAR;
        }
        PG8_STAMP();
        if constexpr (!Epi::AFTER_DRAIN) { E(acc, cur, wr, wc, fr, fq); S.done(cur); }
        PG8_STAMP();
        if (!has_next) break;
#pragma unroll
        for (int a = 0; a < 2; ++a)
#pragma unroll
            for (int b = 0; b < 2; ++b)
#pragma unroll
                for (int m = 0; m < 4; ++m)
#pragma unroll
                    for (int n = 0; n < 2; ++n) acc[a][b][m][n] = (f32x4){0.f, 0.f, 0.f, 0.f};
        cur = nxt; cA = nA; cB = nB; ++ui;
    }
    PG8_WAIT_V(0);
    if (wr == 0) PG8_BAR;
    PG8_BAR;
    if constexpr (Epi::AFTER_DRAIN) { E.fused(acc, cur, wr, wc, fr, fq, lds, wid, lane); S.done(cur); }
    PG8_STAMP();
    if (STAMP && wid == 0) { stamps[lane] = lane < nts ? (((unsigned long long)(unsigned)ts_hi << 32) | (unsigned)ts_lo) : 0ull;
        if (lane == 62) stamps[62] = rt_entry; if (lane == 63) stamps[63] = (unsigned long long)wall_clock64(); }
#undef PG8_STAMP
#undef PG8_SA
#undef PG8_SB
#undef PG8_STAGE
#undef PG8_LDA
#undef PG8_LDB
#undef PG8_MMA
#undef PG8_WAIT_V
#undef PG8_WAIT_L
#undef PG8_BAR
#undef PG8_SCHED
}
}
#define LAS __attribute__((address_space(3)))
#include <cstdlib>
#include <vector>

#define XB_TMO      128
#define XB_XCNT(j)  (256  + 64 * (j))
#define XB_XSUB(j)  (1280 + 64 * (j))
#define XB_XGEN(j)  (2304 + 64 * (j))
#define XB_TOP      3328
#define XB_TOPGEN   3392
#define XCD_BAR_WORDS 3456
#define XB_SPIN_CAP (1u << 18)

__device__ __forceinline__ unsigned xb_ld(unsigned* p)              { return __hip_atomic_load(p, __ATOMIC_RELAXED, __HIP_MEMORY_SCOPE_AGENT); }
__device__ __forceinline__ unsigned xb_add(unsigned* p, unsigned v) { return __hip_atomic_fetch_add(p, v, __ATOMIC_RELAXED, __HIP_MEMORY_SCOPE_AGENT); }
__device__ __forceinline__ unsigned xb_xcc_id() { return (unsigned)__builtin_amdgcn_s_getreg((3 << 11) | 20) & 0xFu; }
#define XB_SPIN(cond, bar) do { unsigned _sp = 0; while (cond) { __builtin_amdgcn_s_sleep(1); \
    if ((++_sp & 255u) == 0u) { if (xb_ld(&(bar)[XB_TMO])) break; if (_sp > XB_SPIN_CAP) { atomicAdd(&(bar)[XB_TMO], 1u); break; } } } } while (0)

struct XcdBarrier {
    unsigned* bar; unsigned x;
    volatile LAS unsigned* st;
};

__device__ __forceinline__ XcdBarrier xcd_barrier_post(unsigned* bar, volatile LAS unsigned* st) {
    XcdBarrier b; b.bar = bar; b.x = xb_xcc_id(); b.st = st;
    if (threadIdx.x == 0) (void)xb_add(&bar[XB_XCNT(b.x)], 1u);
    return b;
}
__device__ __forceinline__ void xcd_barrier_complete(unsigned* bar, unsigned x, unsigned& nloc, unsigned& nx) {
    const unsigned G = gridDim.x * gridDim.y * gridDim.z;
    unsigned sum, cnt, mine, sp = 0u;
    for (;;) {
        sum = 0u; cnt = 0u; mine = 0u;
#pragma unroll
        for (unsigned j = 0; j < 16; ++j) { const unsigned c = xb_ld(&bar[XB_XCNT(j)]); sum += c; cnt += (c > 0u) ? 1u : 0u; mine = (j == x) ? c : mine; }
        if (sum == G) break;
        __builtin_amdgcn_s_sleep(1);
        if ((++sp & 255u) == 0u) { if (xb_ld(&bar[XB_TMO])) break; if (sp > XB_SPIN_CAP) { atomicAdd(&bar[XB_TMO], 1u); break; } }
    }
    nloc = mine > 0u ? mine : 1u; nx = cnt > 0u ? cnt : 1u;
}

__device__ __forceinline__ void xcd_barrier(const XcdBarrier& b) {
    asm volatile("s_waitcnt vmcnt(0)" ::: "memory");
    __syncthreads();
    if (threadIdx.x == 0) {
        unsigned* bar = b.bar;
        __builtin_amdgcn_s_waitcnt(0);
        unsigned nloc = b.st[0], nx = b.st[1];
        if (nloc == 0u) { xcd_barrier_complete(bar, b.x, nloc, nx); b.st[0] = nloc; b.st[1] = nx; }
        const unsigned old = xb_add(&bar[XB_XSUB(b.x)], 1u);
        const unsigned gen = old / nloc;
        if (old + 1u == (gen + 1u) * nloc) {
            __builtin_amdgcn_fence(__ATOMIC_RELEASE, "agent");
            asm volatile("s_waitcnt vmcnt(0)" ::: "memory");
            const unsigned og = xb_add(&bar[XB_TOP], 1u);
            const unsigned tg = og / nx;
            if (og + 1u == (tg + 1u) * nx) xb_add(&bar[XB_TOPGEN], 1u);
            else XB_SPIN(xb_ld(&bar[XB_TOPGEN]) == tg, bar);
            __builtin_amdgcn_fence(__ATOMIC_ACQUIRE, "agent");
            xb_add(&bar[XB_XGEN(b.x)], 1u);
            asm volatile("s_waitcnt vmcnt(0)" ::: "memory");
        } else {
            XB_SPIN(xb_ld(&bar[XB_XGEN(b.x)]) == gen, bar);
            __builtin_amdgcn_fence(__ATOMIC_ACQUIRE, "agent");
            asm volatile("s_waitcnt vmcnt(0)" ::: "memory");
        }
    }
    __syncthreads();
}

using namespace pg8;
#define LAS __attribute__((address_space(3)))
typedef unsigned u32x2 __attribute__((ext_vector_type(2)));

constexpr int MTOK = 20480, MCTX = 4096;
constexpr float ALPHA = 1.41421356237f;
constexpr float QSCALE = 0.125f * 1.44269504089f;
#define GAS __attribute__((address_space(1)))
struct ParamsH { const float* in[33]; float* out; unsigned char* ws; };
struct Params { const float* in[33]; float* out; unsigned char* ws; };
typedef const __attribute__((address_space(3))) Params& PR;
__device__ __forceinline__ const GAS float* gin(PR P, int i) { return (const GAS float*)P.in[i]; }
__device__ __forceinline__ GAS float* gout(PR P) { return (GAS float*)P.out; }
__device__ __forceinline__ GAS unsigned char* gws(PR P) { return (GAS unsigned char*)P.ws; }
enum { I_XP = 0, I_XS, I_SRW, I_SGLA, I_CK, I_CV, I_C, I_CCTX, I_WADA, I_BADA, I_LNG, I_LNB, I_WG, I_WU, I_WDN, I_WIN, I_WOUT,
       I_MU, I_KK, I_KA, I_W0, I_WUP, I_A0, I_AUP, I_GUP, I_RK, I_GNG, I_GNB, I_GAUP, I_GAB, I_GGN, I_LAM, I_DGN };
constexpr size_t O_Y = 0, O_NRW = 20971520, O_NGLA = 22020096, O_NK = 22544384, O_NV = 26738688;
constexpr size_t WS_CTL = 0;
constexpr size_t WS_XBAR = 1024;
constexpr size_t WS_COND = 16384;
constexpr size_t WS_WGU = WS_COND + 663552;
constexpr size_t WS_WD = WS_WGU + 2ull * 5632 * 1024 * 2;
constexpr size_t WS_WIN = WS_WD + 2ull * 1024 * 2816 * 2;
constexpr size_t WS_WOUT = WS_WIN + 4096ull * 1024 * 2;
constexpr size_t WS_WLORA = WS_WOUT + 1024ull * 1536 * 2;
constexpr size_t WS_H = WS_WLORA + 2ull * 768 * 256 * 2;
constexpr size_t WS_BIG = WS_H + 20480ull * 1536 * 2;
constexpr size_t WS_ACT = WS_BIG;
constexpr size_t WS_H3 = WS_BIG + 125829120;
constexpr size_t WS_P = WS_BIG;
constexpr size_t WS_Q = WS_P + 20480ull * 2336 * 2;
constexpr size_t WS_K = WS_Q + 20480ull * 512 * 2;
constexpr size_t WS_VT = WS_K + 24576ull * 512 * 2;
constexpr size_t WS_EAG = WS_VT + 24576ull * 512 * 2;
constexpr size_t WS_GLA = WS_EAG + 2ull * 20480 * 768 * 2;
constexpr size_t WS_END = WS_GLA + 2ull * 20480 * 128 * 4;
constexpr size_t VT_LAT_OFF = 16ull * 512 * 256;

__device__ __forceinline__ int ltid() { int t = threadIdx.x; asm volatile("" : "+v"(t)); return t; }
__device__ __forceinline__ int lbid() { int t = blockIdx.x; asm volatile("" : "+s"(t)); return t; }
__device__ __forceinline__ int condrow(int m) { return m < MCTX ? 0 : 1 + ((m - MCTX) >> 11); }
template <int CTRL> __device__ __forceinline__ float dppx(float x) { return __int_as_float(__builtin_amdgcn_update_dpp(0, __float_as_int(x), CTRL, 0xf, 0xf, false)); }
typedef unsigned u32v2 __attribute__((ext_vector_type(2)));
__device__ __forceinline__ float xrow_sum4(float x) {
    unsigned xi = __float_as_uint(x); u32v2 r = __builtin_amdgcn_permlane16_swap(xi, xi, false, false);
    const float s = __uint_as_float(r[0]) + __uint_as_float(r[1]);
    unsigned si = __float_as_uint(s); u32v2 q = __builtin_amdgcn_permlane32_swap(si, si, false, false);
    return __uint_as_float(q[0]) + __uint_as_float(q[1]);
}
__device__ __forceinline__ float xhalf_sum(float x) { unsigned xi = __float_as_uint(x); u32v2 q = __builtin_amdgcn_permlane32_swap(xi, xi, false, false); return __uint_as_float(q[0]) + __uint_as_float(q[1]); }
__device__ __forceinline__ float xhalf_max(float x) { unsigned xi = __float_as_uint(x); u32v2 q = __builtin_amdgcn_permlane32_swap(xi, xi, false, false); return fmaxf(__uint_as_float(q[0]), __uint_as_float(q[1])); }
__device__ __forceinline__ float wave_sum(float v) {
    v += dppx<0xB1>(v); v += dppx<0x4E>(v); v += dppx<0x141>(v); v += dppx<0x140>(v);
    return xrow_sum4(v);
}
__device__ __forceinline__ float bf2f(bf16_t b) { return __uint_as_float(((unsigned)b) << 16); }
__device__ __forceinline__ bf16_t f2bf(float f) { return (bf16_t)(cvt_pk_bf16(f, 0.f) & 0xffffu); }

__device__ __forceinline__ float wsrc(PR P, int l, int type, int f, int r, int k) {
    if (type == 0) { const int g = r >> 5, i = r & 31; const GAS float* src = (i < 16 ? gin(P, I_WG) : gin(P, I_WU)) + ((size_t)(l * 2 + f) * 1024 + k) * 2816; return src[16 * g + (i & 15)]; }
    if (type == 1) return gin(P, I_WDN)[((size_t)(l * 2 + f) * 2816 + k) * 1024 + r];
    if (type == 2) { int col; if (r < 512) col = 2336 + r; else if (r < 1024) col = 2848 + (r - 512); else if (r < 2304) col = r - 1024; else if (r < 3360) col = 1280 + (r - 2304); else if (r < 3584) return 0.f; else col = 3360 + (r - 3584);
        return gin(P, I_WIN)[((size_t)l * 1024 + k) * 3872 + col]; }
    if (type == 3) { const int kr = k < 512 ? (k & 255) : (k < 1024 ? 256 + ((k - 512) & 255) : k - 512);
        return gin(P, I_WOUT)[((size_t)l * 1024 + kr) * 1024 + r]; }
    const int d = r / 768, rr = r % 768, n = rr & 255;
    if (rr < 256) return k < 64 ? gin(P, I_WUP)[((size_t)(l * 2 + d) * 64 + k) * 256 + n] : 0.f;
    if (rr < 512) return (k >= 64 && k < 128) ? gin(P, I_AUP)[((size_t)(l * 2 + d) * 64 + (k - 64)) * 256 + n] : 0.f;
    return k >= 128 ? gin(P, I_GUP)[((size_t)(l * 2 + d) * 128 + (k - 128)) * 256 + n] : 0.f;
}
__device__ __forceinline__ void convert_weights(PR P, int l, LAS float* tile) {
    const int tid = ltid();
    for (int u = lbid(); u < 1432; u += gridDim.x) {
        int type, f = 0, rt, kt, K; GAS bf16_t* dst; int v = u;
        if (v < 704) { type = 0; f = v / 352; v %= 352; rt = v / 4; kt = v % 4; K = 1024; dst = (GAS bf16_t*)(gws(P) + WS_WGU) + (size_t)f * 5632 * 1024; }
        else if ((v -= 704) < 352) { type = 1; f = v / 176; v %= 176; rt = v / 11; kt = v % 11; K = 2816; dst = (GAS bf16_t*)(gws(P) + WS_WD) + (size_t)f * 1024 * 2816; }
        else if ((v -= 352) < 256) { type = 2; rt = v / 4; kt = v % 4; K = 1024; dst = (GAS bf16_t*)(gws(P) + WS_WIN); }
        else if ((v -= 256) < 96) { type = 3; rt = v / 6; kt = v % 6; K = 1536; dst = (GAS bf16_t*)(gws(P) + WS_WOUT); }
        else { v -= 96; type = 4; rt = v; kt = 0; K = 256; dst = (GAS bf16_t*)(gws(P) + WS_WLORA); }
        const int r0 = rt * 64, k0 = kt * 256;
        { const int rl = tid & 63, kb = tid >> 6; float val[32];
#pragma unroll
          for (int j = 0; j < 32; ++j) val[j] = wsrc(P, l, type, f, r0 + rl, k0 + kb + 8 * j);
#pragma unroll
          for (int j = 0; j < 32; ++j) tile[rl * 257 + kb + 8 * j] = val[j]; }
        __syncthreads();
        { const int rl = tid >> 3;
#pragma unroll
          for (int jj = 0; jj < 4; ++jj) { const int ks = (tid & 7) * 8 + jj * 64; const LAS float* t = tile + rl * 257 + ks;
            u32x4 w; w.x = cvt_pk_bf16(t[0], t[1]); w.y = cvt_pk_bf16(t[2], t[3]); w.z = cvt_pk_bf16(t[4], t[5]); w.w = cvt_pk_bf16(t[6], t[7]);
            *(GAS u32x4*)(dst + (size_t)(r0 + rl) * K + k0 + ks) = w; } }
        __syncthreads();
    }
}
__device__ __forceinline__ void cond_phase(PR P, LAS float* lf) {
    const int tid = ltid(), lane = tid & 63, w = tid >> 6;
    LAS float* sc = lf; LAS float* red = lf + 9 * 1024;
    for (int i = tid; i < 9 * 1024; i += 512) { const int j = i >> 10, k = i & 1023; const float c = (j == 0) ? gin(P, I_CCTX)[k] : gin(P, I_C)[(j - 1) * 1024 + k]; sc[i] = c / (1.f + expf(-c)); }
    __syncthreads();
    for (int u = lbid(); u < 288; u += gridDim.x) {
        const int l = u / 144, n0 = (u % 144) * 64;
        const GAS float* wa = gin(P, I_WADA) + (size_t)l * 1024 * 9216 + n0 + lane;
        float acc[9];
#pragma unroll
        for (int j = 0; j < 9; ++j) acc[j] = 0.f;
#pragma unroll 4
        for (int k = w * 128; k < w * 128 + 128; k += 4) {
            const float w0 = wa[(size_t)k * 9216], w1 = wa[(size_t)(k + 1) * 9216], w2 = wa[(size_t)(k + 2) * 9216], w3 = wa[(size_t)(k + 3) * 9216];
#pragma unroll
            for (int j = 0; j < 9; ++j) { const f32x4 s = *(const LAS f32x4*)(sc + j * 1024 + k); acc[j] += s.x * w0 + s.y * w1 + s.z * w2 + s.w * w3; }
        }
#pragma unroll
        for (int j = 0; j < 9; ++j) red[(w * 9 + j) * 64 + lane] = acc[j];
        __syncthreads();
        for (int i = tid; i < 576; i += 512) { const int j = i >> 6, ln = i & 63; float s = 0.f;
#pragma unroll
            for (int ww = 0; ww < 8; ++ww) s += red[(ww * 9 + j) * 64 + ln];
            ((GAS float*)(gws(P) + WS_COND))[((size_t)l * 9 + j) * 9216 + n0 + ln] = s + gin(P, I_BADA)[l * 9216 + n0 + ln]; }
        __syncthreads();
    }
}
__device__ __forceinline__ void mod_phase0(PR P) {
    GAS bf16_t* H = (GAS bf16_t*)(gws(P) + WS_H); const GAS float* cond = (const GAS float*)(gws(P) + WS_COND);
    const int lane = ltid() & 63, w = ltid() >> 6; const int stride = (int)gridDim.x * 8;
    for (int m0 = lbid() * 8 + w; m0 < MTOK; m0 += 2 * stride) {
        f32x4 xv[2][4];
#pragma unroll
        for (int r = 0; r < 2; ++r) { const int m = m0 + r * stride; if (m < MTOK) { const GAS float* x = ((m < MCTX) ? gin(P, I_XP) + (size_t)m * 1024 : gin(P, I_XS) + (size_t)(m - MCTX) * 1024) + lane * 4;
#pragma unroll
            for (int i = 0; i < 4; ++i) xv[r][i] = *(const GAS f32x4*)(x + i * 256); } }
#pragma unroll
        for (int r = 0; r < 2; ++r) { const int m = m0 + r * stride; if (m >= MTOK) continue;
            const GAS float* cr = cond + (size_t)condrow(m) * 9216 + lane * 4;
#pragma unroll
            for (int i = 0; i < 4; ++i) { const f32x4 sh = *(const GAS f32x4*)(cr + i * 256), sc = *(const GAS f32x4*)(cr + 1024 + i * 256); const f32x4 h = xv[r][i] * (1.f + sc) + sh;
                u32x2 wv; wv.x = cvt_pk_bf16(h[0], h[1]); wv.y = cvt_pk_bf16(h[2], h[3]); *(GAS u32x2*)(H + (size_t)m * 1024 + i * 256 + lane * 4) = wv; } }
    }
}
__device__ __forceinline__ void ln_phase(PR P, int l, int which, int nextmod, int lc, int row_lo, int row_hi, int nblk, int bidx) {
    GAS float* X = gout(P); GAS bf16_t* H = (GAS bf16_t*)(gws(P) + (which == 1 ? WS_H3 : WS_H));
    const GAS float* g = gin(P, I_LNG) + (l * 3 + which) * 1024; const GAS float* b = gin(P, I_LNB) + (l * 3 + which) * 1024;
    const GAS float* cond = (const GAS float*)(gws(P) + WS_COND) + (size_t)lc * 9 * 9216;
    const int lane = ltid() & 63, w = ltid() >> 6;
    for (int m = row_lo + bidx * 8 + w; m < row_hi; m += nblk * 8) {
        GAS float* xr = X + (size_t)m * 1024 + lane * 4;
        f32x4 v[4]; float s = 0.f;
#pragma unroll
        for (int i = 0; i < 4; ++i) { v[i] = *(const GAS f32x4*)(xr + i * 256); s += (v[i][0] + v[i][1]) + (v[i][2] + v[i][3]); }
        const float mu = wave_sum(s) * (1.f / 1024.f);
        float q = 0.f;
#pragma unroll
        for (int i = 0; i < 4; ++i) { const f32x4 d = v[i] - mu; q += (d[0] * d[0] + d[1] * d[1]) + (d[2] * d[2] + d[3] * d[3]); }
        const float rstd = 1.0f / sqrtf(wave_sum(q) * (1.f / 1024.f) + 1e-5f);
        const GAS float* cr = cond + (size_t)condrow(m) * 9216 + nextmod * 1024 + lane * 4;
#pragma unroll
        for (int i = 0; i < 4; ++i) {
            const f32x4 gv = *(const GAS f32x4*)(g + i * 256 + lane * 4), bv = *(const GAS f32x4*)(b + i * 256 + lane * 4);
            const f32x4 y = (v[i] - mu) * rstd * gv + bv;
            *(GAS f32x4*)(xr + i * 256) = y;
            if (nextmod >= 0) { const f32x4 sh = *(const GAS f32x4*)(cr + i * 256), sc = *(const GAS f32x4*)(cr + 1024 + i * 256); const f32x4 h = y * (1.f + sc) + sh;
                u32x2 wv; wv.x = cvt_pk_bf16(h[0], h[1]); wv.y = cvt_pk_bf16(h[2], h[3]); *(GAS u32x2*)(H + (size_t)m * 1024 + i * 256 + lane * 4) = wv; }
        }
    }
}
struct EpiAct {
    static constexpr bool PERM = false, AFTER_DRAIN = false; GAS bf16_t* O;
    __device__ __forceinline__ void operator()(const f32x4 (&acc)[2][2][4][2], const Unit& u, int wr, int wc, int fr, int fq) const {
        const int row0 = u.pm * 256 + wr * 64 + fr, ff0 = u.pn * 128 + wc * 16 + 4 * fq;
#pragma unroll
        for (int ai = 0; ai < 2; ++ai)
#pragma unroll
            for (int m = 0; m < 4; ++m) { GAS bf16_t* rowp = O + (size_t)(row0 + ai * 128 + m * 16) * 2816 + ff0;
#pragma unroll
                for (int bj = 0; bj < 2; ++bj) { const f32x4 g = acc[ai][bj][m][0], up = acc[ai][bj][m][1]; float a[4];
#pragma unroll
                    for (int j = 0; j < 4; ++j) a[j] = g[j] * __builtin_amdgcn_rcpf(1.f + __expf(-g[j])) * up[j];
                    u32x2 w; w.x = cvt_pk_bf16(a[0], a[1]); w.y = cvt_pk_bf16(a[2], a[3]); *(GAS u32x2*)(rowp + bj * 64) = w; } }
    }
};
struct EpiRes {
    static constexpr bool PERM = false, AFTER_DRAIN = false; const GAS float* xp; const GAS float* xs; GAS float* X; const GAS float* cond; int gidx; float gs; int row_off;
    __device__ __forceinline__ void operator()(const f32x4 (&acc)[2][2][4][2], const Unit& u, int wr, int wc, int fr, int fq) const {
        const int row0 = row_off + u.pm * 256 + wr * 64 + fr, col0 = u.pn * 256 + wc * 32 + 4 * fq;
        const GAS float* gr = cond + (size_t)condrow(row_off + u.pm * 256) * 9216 + gidx * 1024 + col0;
        f32x4 gv[2][2];
#pragma unroll
        for (int bj = 0; bj < 2; ++bj)
#pragma unroll
            for (int n = 0; n < 2; ++n) gv[bj][n] = gs * *(const GAS f32x4*)(gr + bj * 128 + n * 16);
#pragma unroll
        for (int ai = 0; ai < 2; ++ai)
#pragma unroll
            for (int m = 0; m < 4; ++m) { const int row = row0 + ai * 128 + m * 16;
                const GAS float* xr = (row < MCTX ? xp + (size_t)row * 1024 : xs + (size_t)(row - MCTX) * 1024) + col0;
                GAS float* o = X + (size_t)row * 1024 + col0;
#pragma unroll
                for (int bj = 0; bj < 2; ++bj)
#pragma unroll
                    for (int n = 0; n < 2; ++n) { const int off = bj * 128 + n * 16; const f32x4 xv = *(const GAS f32x4*)(xr + off);
                        *(GAS f32x4*)(o + off) = ALPHA * xv + gv[bj][n] * acc[ai][bj][m][n]; } }
    }
};
struct EpiIn {
    static constexpr bool PERM = false, AFTER_DRAIN = false; GAS bf16_t* Q; GAS bf16_t* Kb; GAS bf16_t* Pb; GAS float* newk;
    __device__ __forceinline__ void operator()(const f32x4 (&acc)[2][2][4][2], const Unit& u, int wr, int wc, int fr, int fq) const {
        const int row0 = u.pm * 256 + wr * 64 + fr;
        if (u.pn >= 4) {
            const int colbase = (u.pn - 4) * 256 + wc * 32 + 4 * fq;
#pragma unroll
            for (int ai = 0; ai < 2; ++ai)
#pragma unroll
                for (int m = 0; m < 4; ++m) { GAS bf16_t* rowp = Pb + (size_t)(row0 + ai * 128 + m * 16) * 2336;
#pragma unroll
                    for (int bj = 0; bj < 2; ++bj)
#pragma unroll
                        for (int n = 0; n < 2; ++n) { const int col = colbase + bj * 128 + n * 16; const f32x4 a = acc[ai][bj][m][n];
                            if (col < 2336) { u32x2 w; w.x = cvt_pk_bf16(a[0], a[1]); w.y = cvt_pk_bf16(a[2], a[3]); *(GAS u32x2*)(rowp + col) = w; } } }
        } else {
            const bool isK = u.pn >= 2, lat = u.pm >= 16;
            const int chbase = (u.pn & 1) * 256 + wc * 32 + 4 * fq;
            float invf[4];
#pragma unroll
            for (int j = 0; j < 4; ++j) invf[j] = __builtin_amdgcn_exp2f(-(float)(4 * fq + j) * 0.83048202372f) * 0.15915494309f;
#pragma unroll
            for (int ai = 0; ai < 2; ++ai)
#pragma unroll
                for (int m = 0; m < 4; ++m) { const int row = row0 + ai * 128 + m * 16;
                    float cs[4], sn[4]; int t = 0, b = 0;
                    if (lat) { t = (row - MCTX) & 2047; b = (row - MCTX) >> 11; const float pos = (float)((wc & 1) ? (t & 63) : (t >> 6));
#pragma unroll
                        for (int j = 0; j < 4; ++j) { const float rev = pos * invf[j]; cs[j] = __builtin_amdgcn_cosf(rev); sn[j] = __builtin_amdgcn_sinf(rev); } }
                    else {
#pragma unroll
                        for (int j = 0; j < 4; ++j) { cs[j] = 1.f; sn[j] = 0.f; } }
#pragma unroll
                    for (int bj = 0; bj < 2; ++bj) { const f32x4 x1 = acc[ai][bj][m][0], x2 = acc[ai][bj][m][1]; float o1[4], o2[4];
#pragma unroll
                        for (int j = 0; j < 4; ++j) { o1[j] = x1[j] * cs[j] - x2[j] * sn[j]; o2[j] = x1[j] * sn[j] + x2[j] * cs[j]; }
                        const int ch = chbase + bj * 128;
                        if (!isK) { GAS bf16_t* q = Q + (size_t)row * 512 + ch; u32x2 w;
                            w.x = cvt_pk_bf16(o1[0] * QSCALE, o1[1] * QSCALE); w.y = cvt_pk_bf16(o1[2] * QSCALE, o1[3] * QSCALE); *(GAS u32x2*)q = w;
                            w.x = cvt_pk_bf16(o2[0] * QSCALE, o2[1] * QSCALE); w.y = cvt_pk_bf16(o2[2] * QSCALE, o2[3] * QSCALE); *(GAS u32x2*)(q + 16) = w; }
                        else { const size_t krow = lat ? (size_t)(MCTX + b * 2560 + t) : (size_t)row; GAS bf16_t* kp = Kb + krow * 512 + ch; u32x2 w;
                            w.x = cvt_pk_bf16(o1[0], o1[1]); w.y = cvt_pk_bf16(o1[2], o1[3]); *(GAS u32x2*)kp = w;
                            w.x = cvt_pk_bf16(o2[0], o2[1]); w.y = cvt_pk_bf16(o2[2], o2[3]); *(GAS u32x2*)(kp + 16) = w;
                            if (!lat) { GAS float* nk = newk + ((size_t)(row >> 8) * 512 + (row & 255)) * 512 + ch; *(GAS f32x4*)nk = x1; *(GAS f32x4*)(nk + 16) = x2; } } } }
        }
    }
};
struct EpiLora {
    static constexpr bool PERM = false, AFTER_DRAIN = false; GAS bf16_t* O; const GAS float* w0; const GAS float* a0;
    __device__ __forceinline__ void operator()(const f32x4 (&acc)[2][2][4][2], const Unit& u, int wr, int wc, int fr, int fq) const {
        const int row0 = u.pm * 256 + wr * 64 + fr, c0 = wc * 32 + 4 * fq;
#pragma unroll
        for (int bj = 0; bj < 2; ++bj)
#pragma unroll
            for (int n = 0; n < 2; ++n) { const int col = c0 + bj * 128 + n * 16; f32x4 bias = (f32x4){0.f, 0.f, 0.f, 0.f};
                if (u.pn == 0) bias = *(const GAS f32x4*)(w0 + col); else if (u.pn == 1) bias = *(const GAS f32x4*)(a0 + col);
#pragma unroll
                for (int ai = 0; ai < 2; ++ai)
#pragma unroll
                    for (int m = 0; m < 4; ++m) { f32x4 v = acc[ai][bj][m][n] + bias;
                        if (u.pn < 2) { const float sc = u.pn == 0 ? 0.60653065971f : 1.f;
#pragma unroll
                            for (int j = 0; j < 4; ++j) v[j] = sc * __builtin_amdgcn_rcpf(1.f + __expf(-v[j])); }
                        u32x2 w; w.x = cvt_pk_bf16(v[0], v[1]); w.y = cvt_pk_bf16(v[2], v[3]);
                        *(GAS u32x2*)(O + (size_t)(row0 + ai * 128 + m * 16) * 768 + u.pn * 256 + col) = w; } }
    }
};
struct EpiVt {
    static constexpr bool PERM = false, AFTER_DRAIN = false; GAS bf16_t* Vt; GAS float* newv;
    __device__ __forceinline__ void operator()(const f32x4 (&acc)[2][2][4][2], const Unit& u, int wr, int wc, int fr, int fq) const {
        const int ch0 = u.pm * 256 + wr * 64 + fr, tok0 = u.pn * 256 + wc * 32 + 4 * fq;
#pragma unroll
        for (int ai = 0; ai < 2; ++ai)
#pragma unroll
            for (int m = 0; m < 4; ++m) { const int ch = ch0 + ai * 128 + m * 16;
#pragma unroll
                for (int bj = 0; bj < 2; ++bj)
#pragma unroll
                    for (int n = 0; n < 2; ++n) { const int tok = tok0 + bj * 128 + n * 16; const f32x4 a = acc[ai][bj][m][n]; size_t addr;
                        if (u.pn < 16) { const int b = u.pn, t = tok - 256 * b; addr = ((size_t)(b * 512 + ch)) * 256 + t; GAS float* nv = newv + ((size_t)b * 512 + t) * 512 + ch;
                            nv[0] = a[0]; nv[512] = a[1]; nv[1024] = a[2]; nv[1536] = a[3]; }
                        else { const int tl = tok - MCTX, b = tl >> 11, t = tl & 2047; addr = VT_LAT_OFF + ((size_t)(b * 512 + ch)) * 2560 + t; }
                        u32x2 w; w.x = cvt_pk_bf16(a[0], a[1]); w.y = cvt_pk_bf16(a[2], a[3]); *(GAS u32x2*)(Vt + addr) = w; } }
    }
};
__device__ __forceinline__ void prep_phase(PR P, int l, LAS float* lin  ) {
    const int tid = ltid();
    const GAS bf16_t* Pb = (const GAS bf16_t*)(gws(P) + WS_P);
    for (int u = lbid(); u < 1280 + 256; u += gridDim.x) {
        if (u < 1280) {
            const int m0 = u * 16; const bool lat = m0 >= MCTX; const int T = lat ? 2048 : 256; const int t0 = lat ? ((m0 - MCTX) & 2047) : (m0 & 255);
            {
                const int d = tid >> 8, cc = tid & 255, col = 768 + tid;
                const float mu0 = gin(P, I_MU)[(l * 2 + 0) * 1280 + col], mu1 = gin(P, I_MU)[(l * 2 + 1) * 1280 + col];
                const GAS bf16_t* pc = Pb + (size_t)m0 * 2336 + col;
                GAS bf16_t* lo = (GAS bf16_t*)(gws(P) + WS_H) + ((size_t)d * MTOK + m0) * 256 + cc;
                bf16_t raw[18];
                raw[0] = (t0 > 0) ? pc[-2336] : (bf16_t)0;
#pragma unroll
                for (int i = 0; i < 16; ++i) raw[i + 1] = pc[(size_t)i * 2336];
                raw[17] = (t0 + 16 < T) ? pc[(size_t)16 * 2336] : (bf16_t)0;
#pragma unroll
                for (int i = 0; i < 16; ++i) {
                    const float prev = bf2f(raw[i]), cur = bf2f(raw[i + 1]), nxt = bf2f(raw[i + 2]);
                    float v = cur + mu0 * (prev - cur) + mu1 * (nxt - cur);
                    if (cc < 64) v = tanhf(v); else if (cc >= 128) v = 1.f / (1.f + __expf(-v));
                    lo[(size_t)i * 256] = f2bf(v);
                }
            }
        } else {
            const int v = u - 1280, b = v >> 5, j0 = (v & 31) * 16, ch = tid;
            const GAS float* ck = gin(P, I_CK) + ((size_t)(b * 2 + l) * 512 + j0) * 512 + ch; const GAS float* cv = gin(P, I_CV) + ((size_t)(b * 2 + l) * 512 + j0) * 512 + ch;
            GAS bf16_t* Kb = (GAS bf16_t*)(gws(P) + WS_K) + ((size_t)(MCTX + b * 2560 + 2048 + j0)) * 512 + ch;
            float vv[16];
#pragma unroll
            for (int i = 0; i < 16; ++i) { Kb[(size_t)i * 512] = f2bf(ck[(size_t)i * 512]); vv[i] = cv[(size_t)i * 512]; }
            u32x4 w0, w1; w0.x = cvt_pk_bf16(vv[0], vv[1]); w0.y = cvt_pk_bf16(vv[2], vv[3]); w0.z = cvt_pk_bf16(vv[4], vv[5]); w0.w = cvt_pk_bf16(vv[6], vv[7]);
            w1.x = cvt_pk_bf16(vv[8], vv[9]); w1.y = cvt_pk_bf16(vv[10], vv[11]); w1.z = cvt_pk_bf16(vv[12], vv[13]); w1.w = cvt_pk_bf16(vv[14], vv[15]);
            GAS bf16_t* vt = (GAS bf16_t*)(gws(P) + WS_VT) + VT_LAT_OFF + ((size_t)(b * 512 + ch)) * 2560 + 2048 + j0;
            *(GAS u32x4*)vt = w0; *(GAS u32x4*)(vt + 8) = w1;
        }
    }
}

#define FMAC_BC(acc, vec, s, I) asm volatile("v_fmac_f32_dpp %0, %1, %2 row_newbcast:" #I " row_mask:0xf bank_mask:0xf" : "+v"(acc) : "v"(vec), "v"(s))
#define MUL_BC(dst, vec, s, I) asm volatile("v_mul_f32_dpp %0, %1, %2 row_newbcast:" #I " row_mask:0xf bank_mask:0xf" : "=v"(dst) : "v"(vec), "v"(s))
#define REP16(X) X(0) X(1) X(2) X(3) X(4) X(5) X(6) X(7) X(8) X(9) X(10) X(11) X(12) X(13) X(14) X(15)

#define LBAR() do { asm volatile("s_waitcnt lgkmcnt(0)" ::: "memory"); __builtin_amdgcn_s_barrier(); asm volatile("" ::: "memory"); } while (0)
__device__ __forceinline__ void rwkv_block(PR P, int l, int role  , LAS float* lf) {
    const int tid = ltid(), lane = tid & 63, w = __builtin_amdgcn_readfirstlane(tid >> 6), rg = w & 3; const bool helper = w >= 4;
    const bool lat = role < 64; const int s = lat ? role : role - 64;
    const int b = s >> 3, h = (s >> 1) & 3, d = s & 1, T = lat ? 2048 : 256;
    const int mbase = lat ? MCTX + b * 2048 : b * 256;
    LAS float* vec = lf;
    LAS float* post = lf + 12288;
    LAS float* ypart = lf + 16384;
    const GAS bf16_t* Pb = (const GAS bf16_t*)(gws(P) + WS_P); const GAS bf16_t* EAG = (const GAS bf16_t*)(gws(P) + WS_EAG) + (size_t)d * MTOK * 768;
    GAS bf16_t* MX = (GAS bf16_t*)(gws(P) + WS_H);
    const int ch = h * 64 + lane;
    const int nch = T / 16;
    if (!helper) {
        const int r16 = lane & 15, cb = lane >> 4, row = rg * 16 + r16;
        float S[16];
        if (lat) { const GAS float* s0 = gin(P, I_SRW) + ((((size_t)(b * 2 + l) * 2 + d) * 4 + h) * 64 + row) * 64 + cb * 16;
#pragma unroll
            for (int i = 0; i < 16; ++i) S[i] = s0[i]; }
        else {
#pragma unroll
            for (int i = 0; i < 16; ++i) S[i] = 0.f; }
        __builtin_amdgcn_s_waitcnt(0);
        LBAR();
#define RW_LDV(ST, KK_, R_, VROW_, W_, KA_, KD_) do { const LAS float* vp_ = vbuf + ((ST) * 6) * 64; KK_ = vp_[64 + lane]; R_ = vp_[256 + lane]; VROW_ = vp_[320 + row]; \
            _Pragma("unroll") for (int q = 0; q < 4; ++q) { W_[q] = *(const LAS f32x4*)(vp_ + cb * 16 + 4 * q); KA_[q] = *(const LAS f32x4*)(vp_ + 128 + cb * 16 + 4 * q); KD_[q] = *(const LAS f32x4*)(vp_ + 192 + cb * 16 + 4 * q); } } while (0)
#define RW_STEP(ST, KK_, R_, VROW_, W_, KA_, KD_) do { \
            float sa0 = 0.f, sa1 = 0.f, sa2 = 0.f, sa3 = 0.f; \
            REP16(SA_STEP2) \
            const float nsa = -xrow_sum4((sa0 + sa1) + (sa2 + sa3)); \
            _Pragma("unroll") for (int i = 0; i < 16; ++i) S[i] = fmaf(KD_[i >> 2][i & 3], VROW_, fmaf(KA_[i >> 2][i & 3], nsa, S[i] * W_[i >> 2][i & 3])); \
            float y0 = 0.f, y1 = 0.f, y2 = 0.f, y3 = 0.f; \
            REP16(Y_STEP2) \
            ybuf[(ST) * 256 + row * 4 + cb] = (y0 + y1) + (y2 + y3); } while (0)
#pragma unroll 1
        for (int c = 0; c < nch; ++c) {
            const LAS float* vbuf = vec + (c & 1) * 6144; LAS float* ybuf = ypart + (c & 1) * 4096;
            f32x4 Wa[4], KAa[4], KDa[4], Wb[4], KAb[4], KDb[4]; float kka_, ra_, vrowa_, kkb_, rb_, vrowb_;
            RW_LDV(0, kka_, ra_, vrowa_, Wa, KAa, KDa);
#pragma unroll 1
            for (int step = 0; step < 16; step += 2) {
                RW_LDV(step + 1, kkb_, rb_, vrowb_, Wb, KAb, KDb);
#define SA_STEP2(I) if (((I) & 3) == 0) FMAC_BC(sa0, kka_, S[I], I); else if (((I) & 3) == 1) FMAC_BC(sa1, kka_, S[I], I); else if (((I) & 3) == 2) FMAC_BC(sa2, kka_, S[I], I); else FMAC_BC(sa3, kka_, S[I], I);
#define Y_STEP2(I) if (((I) & 3) == 0) FMAC_BC(y0, ra_, S[I], I); else if (((I) & 3) == 1) FMAC_BC(y1, ra_, S[I], I); else if (((I) & 3) == 2) FMAC_BC(y2, ra_, S[I], I); else FMAC_BC(y3, ra_, S[I], I);
                RW_STEP(step, kka_, ra_, vrowa_, Wa, KAa, KDa);
#undef SA_STEP2
#undef Y_STEP2
                if (step + 2 < 16) RW_LDV(step + 2, kka_, ra_, vrowa_, Wa, KAa, KDa);
#define SA_STEP2(I) if (((I) & 3) == 0) FMAC_BC(sa0, kkb_, S[I], I); else if (((I) & 3) == 1) FMAC_BC(sa1, kkb_, S[I], I); else if (((I) & 3) == 2) FMAC_BC(sa2, kkb_, S[I], I); else FMAC_BC(sa3, kkb_, S[I], I);
#define Y_STEP2(I) if (((I) & 3) == 0) FMAC_BC(y0, rb_, S[I], I); else if (((I) & 3) == 1) FMAC_BC(y1, rb_, S[I], I); else if (((I) & 3) == 2) FMAC_BC(y2, rb_, S[I], I); else FMAC_BC(y3, rb_, S[I], I);
                RW_STEP(step + 1, kkb_, rb_, vrowb_, Wb, KAb, KDb);
#undef SA_STEP2
#undef Y_STEP2
            }
            LBAR();
        }
        if (!lat) { GAS float* so = gout(P) + O_NRW + ((((size_t)(b * 2 + l) * 2 + d) * 4 + h) * 64 + row) * 64 + cb * 16;
#pragma unroll
            for (int i = 0; i < 16; ++i) so[i] = S[i]; }
    } else {
        const float mu0r = gin(P, I_MU)[(l * 2) * 1280 + ch], mu1r = gin(P, I_MU)[(l * 2 + 1) * 1280 + ch];
        const float mu0k = gin(P, I_MU)[(l * 2) * 1280 + 256 + ch], mu1k = gin(P, I_MU)[(l * 2 + 1) * 1280 + 256 + ch];
        const float mu0v = gin(P, I_MU)[(l * 2) * 1280 + 512 + ch], mu1v = gin(P, I_MU)[(l * 2 + 1) * 1280 + 512 + ch];
        const float kkc = gin(P, I_KK)[l * 256 + ch], kac = gin(P, I_KA)[l * 256 + ch], rkc = gin(P, I_RK)[(l * 2 + d) * 256 + ch];
        const float gng = gin(P, I_GNG)[(l * 2 + d) * 256 + ch], gnb = gin(P, I_GNB)[(l * 2 + d) * 256 + ch];
        bf16_t Rr[6], Rk[6], Rv[6], Re[4], Ra[4], Rg[4];
#define RW_LOAD(CC) do { const int q0_ = (CC) * 16 + rg * 4, lo_ = d ? T - 4 - q0_ : q0_; \
            _Pragma("unroll") for (int j = 0; j < 6; ++j) { const int tt = lo_ - 1 + j; const bool ok = tt >= 0 && tt < T; const GAS bf16_t* pr = Pb + (size_t)(mbase + tt) * 2336 + ch; \
                Rr[j] = ok ? pr[0] : (bf16_t)0; Rk[j] = ok ? pr[256] : (bf16_t)0; Rv[j] = ok ? pr[512] : (bf16_t)0; } \
            _Pragma("unroll") for (int x = 0; x < 4; ++x) { const GAS bf16_t* eg = EAG + (size_t)(mbase + lo_ + x) * 768 + ch; Re[x] = eg[0]; Ra[x] = eg[256]; Rg[x] = eg[512]; } } while (0)
#define RW_PROCESS(BUF) do { _Pragma("unroll") for (int x = 0; x < 4; ++x) { \
                const int step = rg * 4 + (d ? 3 - x : x); \
                const float r0 = bf2f(Rr[x + 1]), k0 = bf2f(Rk[x + 1]), v0 = bf2f(Rv[x + 1]); \
                const float r = r0 + mu0r * (bf2f(Rr[x]) - r0) + mu1r * (bf2f(Rr[x + 2]) - r0), k = k0 + mu0k * (bf2f(Rk[x]) - k0) + mu1k * (bf2f(Rk[x + 2]) - k0), v = v0 + mu0v * (bf2f(Rv[x]) - v0) + mu1v * (bf2f(Rv[x + 2]) - v0); \
                const float e = bf2f(Re[x]), a = bf2f(Ra[x]), g = bf2f(Rg[x]); \
                const float kkv = k * kkc; const float kk = kkv * __builtin_amdgcn_rsqf(fmaxf(wave_sum(kkv * kkv), 1e-24f)); \
                const float kd = k * (1.f + (a - 1.f) * kac); \
                const float bonus = wave_sum(r * kd * rkc); \
                LAS float* vp_ = vec + (BUF) * 6144 + (step * 6) * 64 + lane; \
                vp_[0] = __expf(-e); vp_[64] = kk; vp_[128] = kk * a; vp_[192] = kd; vp_[256] = r; vp_[320] = v; \
                LAS float* pp = post + (BUF) * 2048 + (step * 2) * 64 + lane; pp[0] = g; pp[64] = bonus * v; } } while (0)
#define RW_POST(CC) do { const int q0_ = (CC) * 16 + rg * 4; \
            _Pragma("unroll") for (int i = 0; i < 4; ++i) { \
                const int step = rg * 4 + i; const int q = q0_ + i, tt = d ? T - 1 - q : q; const int m = mbase + tt; \
                const f32x4 yp = *(const LAS f32x4*)(ypart + ((CC) & 1) * 4096 + step * 256 + lane * 4); \
                const float y = (yp[0] + yp[1]) + (yp[2] + yp[3]); \
                const float mu = wave_sum(y) * (1.f / 64.f); const float dv = y - mu; const float var = wave_sum(dv * dv) * (1.f / 64.f); \
                const LAS float* pp = post + ((CC) & 1) * 2048 + (step * 2) * 64 + lane; \
                const float o = (dv * __builtin_amdgcn_rsqf(var + 64e-5f) * gng + gnb + pp[64]) * pp[0]; \
                MX[(size_t)m * 1536 + d * 256 + ch] = f2bf(o); } } while (0)
        __builtin_amdgcn_s_setprio(2);
        RW_LOAD(0);
        RW_PROCESS(0);
        if (nch > 1) RW_LOAD(1);
        LBAR();
#pragma unroll 1
        for (int c = 0; c < nch; ++c) {
            if (c >= 1) RW_POST(c - 1);
            if (c + 1 < nch) { RW_PROCESS((c + 1) & 1); if (c + 2 < nch) RW_LOAD(c + 2); }
            LBAR();
        }
        RW_POST(nch - 1);
        __builtin_amdgcn_s_setprio(0);
    }
    __syncthreads();
}
#define REP8(X) X(0) X(1) X(2) X(3) X(4) X(5) X(6) X(7)
__device__ __forceinline__ void gla_block(PR P, int l, int role  , LAS float* lf) {
    const int tid = ltid(), lane = tid & 63, w = __builtin_amdgcn_readfirstlane(tid >> 6), kg = w & 3; const bool helper = w >= 4;
    const bool lat = role < 64; const int s = lat ? role : role - 64;
    const int b = s >> 3, h = (s >> 1) & 3, d = s & 1, T = lat ? 2048 : 256;
    const int mbase = lat ? MCTX + b * 2048 : b * 256;
    LAS float* qb = lf;
    LAS float* kb = lf + 1024;
    LAS float* ab = lf + 2048;
    LAS float* vb = lf + 3072;
    LAS float* gb = lf + 5120;
    LAS float* opart = lf + 7168;
    const int nch = T / 16;
    if (!helper) {
        float S[8];
        if (lat) { const GAS float* s0 = gin(P, I_SGLA) + ((((size_t)(b * 2 + l) * 2 + d) * 4 + h) * 32 + kg * 8) * 64 + lane;
#pragma unroll
            for (int k = 0; k < 8; ++k) S[k] = s0[k * 64]; }
        else {
#pragma unroll
            for (int k = 0; k < 8; ++k) S[k] = 0.f; }
        __builtin_amdgcn_s_waitcnt(0);
        const int l7 = kg * 8 + (lane & 7);
        LBAR();
#pragma unroll 1
        for (int c = 0; c < nch; ++c) {
            const int bo = (c & 1);
#pragma unroll 1
            for (int step = 0; step < 16; ++step) {
                const int o_ = (bo * 16 + step) * 32 + l7;
                const float qv = qb[o_], kv = kb[o_], av = ab[o_], v = vb[(bo * 16 + step) * 64 + lane];
                float o0 = 0.f, o1 = 0.f, o2 = 0.f, o3 = 0.f;
#define GLA_A(I) MUL_BC(S[I], av, S[I], I);
#define GLA_B(I) FMAC_BC(S[I], kv, v, I);
#define GLA_C(I) if (((I) & 3) == 0) FMAC_BC(o0, qv, S[I], I); else if (((I) & 3) == 1) FMAC_BC(o1, qv, S[I], I); else if (((I) & 3) == 2) FMAC_BC(o2, qv, S[I], I); else FMAC_BC(o3, qv, S[I], I);
                REP8(GLA_A)
                REP8(GLA_B)
                REP8(GLA_C)
                opart[(bo * 16 + step) * 256 + kg * 64 + lane] = (o0 + o1) + (o2 + o3);
            }
            LBAR();
        }
        if (!lat) { GAS float* so = gout(P) + O_NGLA + ((((size_t)(b * 2 + l) * 2 + d) * 4 + h) * 32 + kg * 8) * 64 + lane;
#pragma unroll
            for (int k = 0; k < 8; ++k) so[k * 64] = S[k]; }
    } else {
        const GAS bf16_t* Pb = (const GAS bf16_t*)(gws(P) + WS_P) + 1280;
        float up[16];
#pragma unroll
        for (int j = 0; j < 16; ++j) up[j] = gin(P, I_GAUP)[((size_t)(l * 2 + d) * 16 + j) * 128 + h * 32 + (lane & 31)];
        const float bb = gin(P, I_GAB)[(l * 2 + d) * 128 + h * 32 + (lane & 31)];
        GAS bf16_t* MX = (GAS bf16_t*)(gws(P) + WS_H);
        const float gn = gin(P, I_GGN)[l * 64 + lane];
        bf16_t Rqk[4], Rv[4], Rg[4]; u32x4 Ra0[4], Ra1[4];
#define GL_LOAD(CC) do { _Pragma("unroll") for (int i = 0; i < 4; ++i) { const int q = (CC) * 16 + kg * 4 + i, tt = d ? T - 1 - q : q; const size_t m = (size_t)(mbase + tt); \
                Rqk[i] = Pb[m * 2336 + (lane < 32 ? 0 : 128 - 32) + h * 32 + lane]; { const GAS bf16_t* ad = Pb + m * 2336 + 512 + 272 * d; Ra0[i] = *(const GAS u32x4*)ad; Ra1[i] = *(const GAS u32x4*)(ad + 8); } \
                Rv[i] = Pb[m * 2336 + 256 + h * 64 + lane]; Rg[i] = Pb[m * 2336 + 512 + 272 * d + 16 + h * 64 + lane]; } } while (0)
#define GL_PROCESS(BUF) do { _Pragma("unroll") for (int i = 0; i < 4; ++i) { const int step = kg * 4 + i; const float x = bf2f(Rqk[i]); \
                float xa = bb; \
                _Pragma("unroll") for (int j = 0; j < 4; ++j) { xa += __uint_as_float(Ra0[i][j] << 16) * up[2 * j] + __uint_as_float(Ra0[i][j] & 0xffff0000u) * up[2 * j + 1]; \
                                                                xa += __uint_as_float(Ra1[i][j] << 16) * up[8 + 2 * j] + __uint_as_float(Ra1[i][j] & 0xffff0000u) * up[8 + 2 * j + 1]; } \
                const float ls = fminf(xa, 0.f) - __logf(1.f + __expf(-fabsf(xa)));     \
                if (lane < 32) { qb[((BUF) * 16 + step) * 32 + lane] = x * 0.17677669529f; ab[((BUF) * 16 + step) * 32 + lane] = __expf(ls * (1.f / 16.f)); } else kb[((BUF) * 16 + step) * 32 + lane - 32] = x; \
                vb[((BUF) * 16 + step) * 64 + lane] = bf2f(Rv[i]); gb[((BUF) * 16 + step) * 64 + lane] = bf2f(Rg[i]); } } while (0)
#define GL_POST(CC) do { _Pragma("unroll") for (int i = 0; i < 4; ++i) { const int step = kg * 4 + i; const int q = (CC) * 16 + step, tt = d ? T - 1 - q : q; const size_t m = (size_t)(mbase + tt); \
                const LAS float* op = opart + ((((CC) & 1)) * 16 + step) * 256 + lane; \
                const float o = (op[0] + op[64]) + (op[128] + op[192]); \
                const float ss = wave_sum(o * o) * (1.f / 64.f); const float gd = gb[(((CC) & 1) * 16 + step) * 64 + lane]; \
                const float r = o * __builtin_amdgcn_rsqf(ss + 1e-6f) * gn * (gd * __builtin_amdgcn_rcpf(1.f + __expf(-gd))); \
                MX[m * 1536 + 512 + d * 256 + h * 64 + lane] = f2bf(r); } } while (0)
        GL_LOAD(0);
        GL_PROCESS(0);
        if (nch > 1) GL_LOAD(1);
        LBAR();
#pragma unroll 1
        for (int c = 0; c < nch; ++c) {
            if (c >= 1) GL_POST(c - 1);
            if (c + 1 < nch) { GL_PROCESS((c + 1) & 1); if (c + 2 < nch) GL_LOAD(c + 2); }
            LBAR();
        }
        GL_POST(nch - 1);
    }
    __syncthreads();
}

typedef float f32x16 __attribute__((ext_vector_type(16)));
constexpr int QPITCH = 144;
constexpr int ATT_STAGE = 12288;
constexpr int ATT_WLDS = 32 * QPITCH + 8192;
__device__ __forceinline__ void attn_block_item(PR P, int l, int it, float lam, float lam_init, LAS unsigned char* lds) {
    const int tid = ltid(), lane = tid & 63, w = __builtin_amdgcn_readfirstlane(tid >> 6), q32 = lane & 31, hh = lane >> 5;
    LAS unsigned char* qlds = lds + 2 * ATT_STAGE + w * ATT_WLDS;
    LAS unsigned* park = (LAS unsigned*)(qlds + 32 * QPITCH);
    int b, h, Tk, m0; size_t krow0, vbase;
    if (it < 256) { b = it >> 5; h = (it >> 3) & 3; const int qb = it & 7; Tk = 2560; m0 = MCTX + b * 2048 + qb * 256 + w * 32; krow0 = (size_t)MCTX + (size_t)b * 2560; vbase = VT_LAT_OFF + ((size_t)(b * 512 + h * 128)) * 2560; }
    else { const int i2 = it - 256; b = i2 >> 2; h = i2 & 3; Tk = 256; m0 = b * 256 + w * 32; krow0 = (size_t)b * 256; vbase = ((size_t)(b * 512 + h * 128)) * 256; }
    const LAS unsigned char* qrd = qlds + q32 * QPITCH + hh * 16;
    const int kr = (tid & 255) >> 3, ksg = tid & 7, ve = tid >> 2, vks = tid & 3;
    const int kmrow = kr < 16 ? ((kr >> 2) * 8 + (kr & 3)) : (((kr - 16) >> 2) * 8 + 4 + (kr & 3));
    const unsigned kdst = (unsigned)((((ksg >> 1) * 64) + kmrow + 32 * (ksg & 1)) * 16);
    const unsigned vdst = (unsigned)(4096 + ((((ve >> 5) * 2 + (vks & 1)) * 64) + (ve & 31) + 32 * (vks >> 1)) * 16);
    const GAS bf16_t* Vg = (const GAS bf16_t*)(gws(P) + WS_VT) + vbase + (size_t)ve * Tk + vks * 8;
    const int ntile = Tk / 32;
#pragma unroll 1
    for (int c = 0; c < 2; ++c) {
        const GAS bf16_t* Kg = (const GAS bf16_t*)(gws(P) + WS_K) + (krow0 + kr) * 512 + h * 128 + c * 64 + ksg * 8;
        {
            const GAS bf16_t* Qg = (const GAS bf16_t*)(gws(P) + WS_Q) + (size_t)(m0 + q32) * 512 + h * 128 + c * 64 + hh * 32;
#pragma unroll
            for (int j = 0; j < 4; ++j) *(LAS u32x4*)(qlds + q32 * QPITCH + hh * 64 + j * 16) = *(const GAS u32x4*)(Qg + j * 8);
        }
        {
            u32x4 kreg = (u32x4){0u, 0u, 0u, 0u}; if (tid < 256) kreg = *(const GAS u32x4*)Kg;
            const u32x4 vreg = *(const GAS u32x4*)Vg;
            if (tid < 256) *(LAS u32x4*)(lds + kdst) = kreg;
            *(LAS u32x4*)(lds + vdst) = vreg;
        }
        LBAR();
        f32x16 O[4];
#pragma unroll
        for (int eb = 0; eb < 4; ++eb)
#pragma unroll
            for (int i = 0; i < 16; ++i) O[eb][i] = 0.f;
        float mrun = -1e30f, lrun = 0.f;
#pragma unroll 1
        for (int t = 0; t < ntile; ++t) {
            const bool more = t + 1 < ntile;
            u32x4 kreg = (u32x4){0u, 0u, 0u, 0u}, vreg = (u32x4){0u, 0u, 0u, 0u};
            if (more) { if (tid < 256) kreg = *(const GAS u32x4*)(Kg + (size_t)(t + 1) * 32 * 512); vreg = *(const GAS u32x4*)(Vg + (t + 1) * 32); }
            const LAS unsigned char* st = lds + (t & 1) * ATT_STAGE + lane * 16;
            f32x16 sc;
#pragma unroll
            for (int i = 0; i < 16; ++i) sc[i] = 0.f;
#pragma unroll
            for (int j = 0; j < 4; ++j) { const bf16x8 kf = *(const LAS bf16x8*)(st + j * 1024); const bf16x8 qf = *(const LAS bf16x8*)(qrd + j * 32); sc = __builtin_amdgcn_mfma_f32_32x32x16_bf16(kf, qf, sc, 0, 0, 0); }
            float mx = sc[0];
#pragma unroll
            for (int i = 1; i < 16; ++i) mx = fmaxf(mx, sc[i]);
            mx = xhalf_max(mx);
            const bool need = mx > mrun + 11.5f;
            if (__builtin_amdgcn_ballot_w64(need) != 0ull) {
                const float mnew = need ? mx : mrun; const float alpha = __builtin_amdgcn_exp2f(mrun - mnew); mrun = mnew; lrun *= alpha;
#pragma unroll
                for (int eb = 0; eb < 4; ++eb)
#pragma unroll
                    for (int i = 0; i < 16; ++i) O[eb][i] *= alpha;
            }
            float p[16]; float rs = 0.f;
#pragma unroll
            for (int i = 0; i < 16; ++i) { p[i] = __builtin_amdgcn_exp2f(sc[i] - mrun); rs += p[i]; }
            lrun += xhalf_sum(rs);
            bf16x8 pf[2];
#pragma unroll
            for (int mm = 0; mm < 2; ++mm) { u32x4 wv;
                asm volatile("v_cvt_pk_bf16_f32 %0, %4, %5\n\tv_cvt_pk_bf16_f32 %1, %6, %7\n\tv_cvt_pk_bf16_f32 %2, %8, %9\n\tv_cvt_pk_bf16_f32 %3, %10, %11\n\ts_nop 1"
                             : "=&v"(wv[0]), "=&v"(wv[1]), "=&v"(wv[2]), "=&v"(wv[3])
                             : "v"(p[8 * mm]), "v"(p[8 * mm + 1]), "v"(p[8 * mm + 2]), "v"(p[8 * mm + 3]), "v"(p[8 * mm + 4]), "v"(p[8 * mm + 5]), "v"(p[8 * mm + 6]), "v"(p[8 * mm + 7]));
                pf[mm] = __builtin_bit_cast(bf16x8, wv); }
#pragma unroll
            for (int eb = 0; eb < 4; ++eb)
#pragma unroll
                for (int mm = 0; mm < 2; ++mm) { const bf16x8 vf = *(const LAS bf16x8*)(st + 4096 + (eb * 2 + mm) * 1024); O[eb] = __builtin_amdgcn_mfma_f32_32x32x16_bf16(vf, pf[mm], O[eb], 0, 0, 0); }
            if (more) { LAS unsigned char* nx = lds + ((t + 1) & 1) * ATT_STAGE; if (tid < 256) *(LAS u32x4*)(nx + kdst) = kreg; *(LAS u32x4*)(nx + vdst) = vreg; }
            LBAR();
        }
        if (c == 0) {
            const float i1 = 1.f / lrun;
#pragma unroll
            for (int eb = 0; eb < 4; ++eb)
#pragma unroll
                for (int i2 = 0; i2 < 8; ++i2) park[(eb * 8 + i2) * 64 + lane] = cvt_pk_bf16(O[eb][2 * i2] * i1, O[eb][2 * i2 + 1] * i1);
        } else {
            const float i2s = lam / lrun; float ss = 0.f;
#pragma unroll
            for (int eb = 0; eb < 4; ++eb)
#pragma unroll
                for (int i2 = 0; i2 < 8; ++i2) { const unsigned wv = park[(eb * 8 + i2) * 64 + lane];
                    const float o0 = __uint_as_float(wv << 16) - O[eb][2 * i2] * i2s, o1 = __uint_as_float(wv & 0xffff0000u) - O[eb][2 * i2 + 1] * i2s;
                    O[eb][2 * i2] = o0; O[eb][2 * i2 + 1] = o1; ss += o0 * o0 + o1 * o1; }
            ss = xhalf_sum(ss);
            const float rn = (1.0f / sqrtf(ss * (1.f / 128.f) + 1e-6f)) * (1.f - lam_init);
            GAS bf16_t* op = (GAS bf16_t*)(gws(P) + WS_H) + (size_t)(m0 + q32) * 1536 + 1024 + h * 128;
            const GAS float* gn = gin(P, I_DGN) + l * 128;
#pragma unroll
            for (int eb = 0; eb < 4; ++eb)
#pragma unroll
                for (int i4 = 0; i4 < 4; ++i4) { const int e = eb * 32 + i4 * 8 + 4 * hh; const f32x4 g = *(const GAS f32x4*)(gn + e);
                    u32x2 wv; wv.x = cvt_pk_bf16(O[eb][i4 * 4] * rn * g[0], O[eb][i4 * 4 + 1] * rn * g[1]); wv.y = cvt_pk_bf16(O[eb][i4 * 4 + 2] * rn * g[2], O[eb][i4 * 4 + 3] * rn * g[3]);
                    *(GAS u32x2*)(op + e) = wv; }
        }
    }
}

__device__ __forceinline__ void mixer_phase(PR P, int l, LAS unsigned char* lds) {
    const int lane = ltid() & 63, w = ltid() >> 6;
    for (int role = lbid(); role < 384; role += gridDim.x) {
        if (role < 128) rwkv_block(P, l, 64 + role, (LAS float*)lds);
        else if (role < 192) rwkv_block(P, l, role - 128, (LAS float*)lds);
        else if (role < 256) gla_block(P, l, role - 192, (LAS float*)lds);
        else gla_block(P, l, 64 + (role - 256), (LAS float*)lds);
    }
    __syncthreads();
    const GAS float* lp = gin(P, I_LAM) + l * 256;
    const float s1 = wave_sum(lp[lane] * lp[64 + lane]), s2 = wave_sum(lp[128 + lane] * lp[192 + lane]);
    const float lam_init = (l == 0) ? 0.2f : 0.35550906759f;
    const float lam = expf(s1) - expf(s2) + lam_init;
    for (;;) {
        LAS unsigned* slot = (LAS unsigned*)(lds + 131072 + 400);
        if (ltid() == 0) *slot = __hip_atomic_fetch_add((GAS unsigned*)(gws(P) + WS_CTL) + l, 1u, __ATOMIC_RELAXED, __HIP_MEMORY_SCOPE_AGENT);
        __syncthreads();
        const unsigned it = (unsigned)__builtin_amdgcn_readfirstlane((int)*slot);
        __syncthreads();
        if (it >= 320u) break;
        attn_block_item(P, l, (int)it, lam, lam_init, lds);
    }
}
__device__ __forceinline__ int lsg(int v) { asm volatile("" : "+s"(v)); return v; }
__device__ __forceinline__ void run_gemm_ffn_up(PR P, LAS unsigned char* lds, int f) {
    Gemm g{(const unsigned short*)((const GAS bf16_t*)(gws(P) + (f == 1 ? WS_H3 : WS_H))), (const unsigned short*)((const GAS bf16_t*)(gws(P) + WS_WGU) + (size_t)f * 5632 * 1024), lsg(MTOK), lsg(5632), lsg(1024)};
    StaticOrder S; S.init(g.M, g.N, (int)gridDim.x, (int)blockIdx.x);
    EpiAct E{(GAS bf16_t*)(gws(P) + WS_ACT)};
    gemm_phase<EpiAct, StaticOrder, false>(lds, g, S, E, nullptr);
}
__device__ __forceinline__ void run_gemm_res(PR P, LAS unsigned char* lds, const GAS bf16_t* A, const GAS bf16_t* Bt, int K, const GAS float* xp, const GAS float* xs, int l, int gidx, float gs, int part) {
    const int G = (int)gridDim.x, bid = lbid();
    if (part == 0) {
        Gemm g{(const unsigned short*)(A + (size_t)MCTX * K), (const unsigned short*)Bt, lsg(MTOK - MCTX), lsg(1024), lsg(K)};
        StaticOrder S; S.init(g.M, g.N, G, bid);
        EpiRes E{xp, xs, gout(P), (const GAS float*)(gws(P) + WS_COND) + (size_t)l * 9 * 9216, gidx, gs, MCTX};
        gemm_phase<EpiRes, StaticOrder, false>(lds, g, S, E, nullptr);
    } else {
        Gemm g{(const unsigned short*)A, (const unsigned short*)Bt, lsg(MCTX), lsg(1024), lsg(K)};
        StaticOrder S; S.init(g.M, g.N, G < 64 ? G : 64, bid);
        EpiRes E{xp, xs, gout(P), (const GAS float*)(gws(P) + WS_COND) + (size_t)l * 9 * 9216, gidx, gs, 0};
        gemm_phase<EpiRes, StaticOrder, false>(lds, g, S, E, nullptr);
    }
}
#define RES_AND_LN(A_, Bt_, K_, xp_, xs_, gidx_, gs_, which_, nextmod_, lc_) do { \
        { PR P = PARAMS; run_gemm_res(P, lds, A_, Bt_, K_, xp_, xs_, l, gidx_, gs_, 0); } \
        gbar(lds); \
        { PR P = PARAMS; const int G_ = (int)gridDim.x, bid_ = lbid(); \
          if (G_ > 64) { if (bid_ < 64) run_gemm_res(P, lds, A_, Bt_, K_, xp_, xs_, l, gidx_, gs_, 1); else ln_phase(P, l, which_, nextmod_, lc_, MCTX, MTOK, G_ - 64, bid_ - 64); } \
          else run_gemm_res(P, lds, A_, Bt_, K_, xp_, xs_, l, gidx_, gs_, 1); } \
        gbar(lds); \
        { PR P = PARAMS; const int G_ = (int)gridDim.x; if (G_ <= 64) ln_phase(P, l, which_, nextmod_, lc_, MCTX, MTOK, G_, lbid()); ln_phase(P, l, which_, nextmod_, lc_, 0, MCTX, G_, lbid()); } \
    } while (0)
__device__ __forceinline__ void run_gemm_in(PR P, LAS unsigned char* lds, int l) {
    { Gemm g{(const unsigned short*)((const GAS bf16_t*)(gws(P) + WS_H)), (const unsigned short*)((const GAS bf16_t*)(gws(P) + WS_WIN)), lsg(MTOK), lsg(3584), lsg(1024)};
      StaticOrder S; S.init(g.M, g.N, (int)gridDim.x, (int)blockIdx.x);
      EpiIn E{(GAS bf16_t*)(gws(P) + WS_Q), (GAS bf16_t*)(gws(P) + WS_K), (GAS bf16_t*)(gws(P) + WS_P), gout(P) + O_NK + (size_t)l * 256 * 512};
      gemm_phase<EpiIn, StaticOrder, false>(lds, g, S, E, nullptr); }
    { Gemm g{(const unsigned short*)((const GAS bf16_t*)(gws(P) + WS_WIN) + (size_t)3584 * 1024), (const unsigned short*)((const GAS bf16_t*)(gws(P) + WS_H)), lsg(512), lsg(MTOK), lsg(1024)};
      const int G = (int)gridDim.x; StaticOrder S; S.init(g.M, g.N, G, (int)((blockIdx.x + G - (1120 % G)) % G));
      EpiVt E{(GAS bf16_t*)(gws(P) + WS_VT), gout(P) + O_NV + (size_t)l * 256 * 512};
      gemm_phase<EpiVt, StaticOrder, false>(lds, g, S, E, nullptr); }
}

__device__ __forceinline__ void run_gemm_lora(PR P, LAS unsigned char* lds, int l) {
#pragma unroll 1
    for (int d = 0; d < 2; ++d) {
        Gemm g{(const unsigned short*)((const GAS bf16_t*)(gws(P) + WS_H) + (size_t)d * MTOK * 256), (const unsigned short*)((const GAS bf16_t*)(gws(P) + WS_WLORA) + (size_t)d * 768 * 256), lsg(MTOK), lsg(768), lsg(256)};
        const int G = (int)gridDim.x; StaticOrder S; S.init(g.M, g.N, G, (int)((lbid() + G - ((d * 240) % G)) % G));
        EpiLora E{(GAS bf16_t*)(gws(P) + WS_EAG) + (size_t)d * MTOK * 768, gin(P, I_W0) + (l * 2 + d) * 256, gin(P, I_A0) + (l * 2 + d) * 256};
        gemm_phase<EpiLora, StaticOrder, false>(lds, g, S, E, nullptr);
    }
}
__device__ __forceinline__ const LAS Params* lpar(LAS unsigned char* lds) { const LAS Params* q = (const LAS Params*)(lds + 131072); asm volatile("" : "+s"(q)); return q; }
#define PARAMS (*lpar(lds))
__device__ __forceinline__ void gbar(LAS unsigned char* lds) {
    PR P = PARAMS; XcdBarrier b; b.bar = (unsigned*)(gws(P) + WS_XBAR); b.x = xb_xcc_id(); b.st = (volatile LAS unsigned*)(lds + 131072 + 384);
    xcd_barrier(b);
}
__global__ void __launch_bounds__(512, 2) mega(ParamsH Pk) {
    extern __shared__ __attribute__((aligned(16))) unsigned char smem[];
    LAS unsigned char* lds = (LAS unsigned char*)smem;
    cg::grid_group grid = cg::this_grid();
    if (threadIdx.x < 35) ((LAS unsigned long long*)(lds + 131072))[threadIdx.x] = ((const __attribute__((address_space(4))) unsigned long long*)__builtin_amdgcn_kernarg_segment_ptr())[threadIdx.x];
    if (threadIdx.x < 2) ((LAS unsigned*)(lds + 131072 + 384))[threadIdx.x] = 0u;
    __syncthreads();
    { PR P = PARAMS; (void)xcd_barrier_post((unsigned*)(gws(P) + WS_XBAR), (volatile LAS unsigned*)(lds + 131072 + 384)); }
    grid.sync();
    convert_weights(PARAMS, 0, (LAS float*)lds);
    cond_phase(PARAMS, (LAS float*)lds);
    gbar(lds);
    mod_phase0(PARAMS);
    gbar(lds);
#pragma unroll 1
    for (int l = 0; l < 2; ++l) {
        run_gemm_ffn_up(PARAMS, lds, 0);
        gbar(lds);
        { const GAS float* xp; const GAS float* xs; { PR P = PARAMS; if (l == 0) { xp = gin(P, I_XP); xs = gin(P, I_XS); } else { xp = gout(P); xs = gout(P) + (size_t)MCTX * 1024; } }
          RES_AND_LN((const GAS bf16_t*)(gws(P) + WS_ACT), (const GAS bf16_t*)(gws(P) + WS_WD), 2816, xp, xs, 2, 0.5f, 0, 3, l); }
        gbar(lds);
        run_gemm_in(PARAMS, lds, l);
        gbar(lds);
        prep_phase(PARAMS, l, (LAS float*)lds);
        gbar(lds);
        run_gemm_lora(PARAMS, lds, l);
        gbar(lds);
        mixer_phase(PARAMS, l, lds);
        gbar(lds);
        RES_AND_LN((const GAS bf16_t*)(gws(P) + WS_H), (const GAS bf16_t*)(gws(P) + WS_WOUT), 1536, gout(P), gout(P) + (size_t)MCTX * 1024, 5, 1.0f, 1, 6, l);
        gbar(lds);
        run_gemm_ffn_up(PARAMS, lds, 1);
        gbar(lds);
        RES_AND_LN((const GAS bf16_t*)(gws(P) + WS_ACT), (const GAS bf16_t*)(gws(P) + WS_WD) + (size_t)1024 * 2816, 2816, gout(P), gout(P) + (size_t)MCTX * 1024, 8, 0.5f, 2, (l == 0 ? 0 : -1), l + 1);
        if (l == 0) convert_weights(PARAMS, 1, (LAS float*)lds);
        gbar(lds);
    }
}
extern "C" void kernel_launch(void* const* d_in, const int* in_sizes, int n_in, void* d_out, int out_size, void* d_ws, size_t ws_size, hipStream_t stream) {
    constexpr size_t kDynLds = 131072 + 512;
    static int grid_blocks = 0;
    if (!grid_blocks) {
        int dev = 0, cus = 0, per_cu = 0;
        hipGetDevice(&dev);
        hipDeviceGetAttribute(&cus, hipDeviceAttributeMultiprocessorCount, dev);
        hipFuncSetAttribute((const void*)mega, hipFuncAttributeMaxDynamicSharedMemorySize, (int)kDynLds);
        hipOccupancyMaxActiveBlocksPerMultiprocessor(&per_cu, (const void*)mega, 512, kDynLds);
        if (per_cu < 1) { fprintf(stderr, "occupancy query says %d blocks/CU\n", per_cu); per_cu = 1; }
        if (per_cu > 1) per_cu = 1;
        grid_blocks = cus * per_cu;
        if (ws_size < WS_END) fprintf(stderr, "workspace too small: %zu < %zu\n", ws_size, (size_t)WS_END);
    }
    ParamsH p{};
    for (int i = 0; i < 33; ++i) p.in[i] = (const float*)d_in[i];
    p.out = (float*)d_out; p.ws = (unsigned char*)d_ws;
    hipMemsetAsync(d_ws, 0, 16384, stream);
    void* args[] = {&p};
    hipError_t e = hipLaunchCooperativeKernel((const void*)mega, dim3(grid_blocks), dim3(512), args, kDynLds, stream);
    if (e != hipSuccess) fprintf(stderr, "cooperative launch failed: %s (grid %d)\n", hipGetErrorString(e), grid_blocks);
}
```
